# Optimizing an MI355X kernel written in HIP

```python
import jax, jax.numpy as jnp
from jax import lax
import numpy as np

D_MODEL = 1024
BATCH = 8
SEQ = 2048
DEPTH = 2

N_HEADS = 16
HEAD_DIM = D_MODEL // N_HEADS
N_MIXERS = 2
GRID_W = 64
NA_ROWS = 8
NA_COLS = 16
DIL_GROUPS = ((128, 1), (512, 4), (2048, 16))
N_GROUPS = len(DIL_GROUPS)
BAND_BLOCK = 128
D_FF = -(-8 * D_MODEL // (3 * 256)) * 256
RMS_EPS = 1e-6
NEG_INF = -1e30
N_A_LAYERS = (DEPTH + 1) // 2
N_B_LAYERS = DEPTH // 2

kernel_name = "hybrid_natten_dilated_encoder"


def rms_norm(x, g):
    xf = x.astype(jnp.float32)
    y = xf * lax.rsqrt(jnp.mean(xf * xf, axis=-1, keepdims=True) + RMS_EPS)
    return (y * g.astype(jnp.float32)).astype(x.dtype)


def alibi_slopes(n):
    return 2.0 ** (-8.0 * jnp.arange(1, n + 1, dtype=jnp.float32) / n)


def swiglu(x, w_gate, w_up, w_down):
    return (jax.nn.silu(x @ w_gate) * (x @ w_up)) @ w_down


def neighbourhood_attention(x, w_qkv, w_o, rpb):
    b, s, _ = x.shape
    rows = s // GRID_W
    kh = min(NA_ROWS, rows)
    qkv = (x @ w_qkv).reshape(b, rows, GRID_W, 3, N_HEADS, HEAD_DIM)
    q, k, v = (jnp.transpose(qkv[:, :, :, i], (0, 3, 1, 2, 4)) for i in range(3))
    q = q * HEAD_DIM ** -0.5
    col = jnp.arange(GRID_W)
    col_start = jnp.clip(col - NA_COLS // 2, 0, GRID_W - NA_COLS)
    col_mask = (col[None, :] >= col_start[:, None]) & (col[None, :] < col_start[:, None] + NA_COLS)
    col_idx = jnp.clip(col[None, :] - col[:, None] + NA_COLS - 1, 0, 2 * NA_COLS - 2)
    rpb_cols = rpb.astype(jnp.float32)[:, :, col_idx]

    def row_block(i):
        rs = jnp.clip(i - kh // 2, 0, rows - kh)
        qi = lax.dynamic_index_in_dim(q, i, axis=2, keepdims=False)
        kr = lax.dynamic_slice_in_dim(k, rs, kh, axis=2)
        vr = lax.dynamic_slice_in_dim(v, rs, kh, axis=2)
        bias = lax.dynamic_slice_in_dim(rpb_cols, rs - i + NA_ROWS - 1, kh, axis=1)
        sc = jnp.einsum('bhqd,bhrkd->bhqrk', qi, kr).astype(jnp.float32)
        sc = sc + jnp.transpose(bias, (0, 2, 1, 3))[None]
        sc = jnp.where(col_mask[:, None, :], sc, NEG_INF)
        p = jax.nn.softmax(sc.reshape(b, N_HEADS, GRID_W, kh * GRID_W), axis=-1).reshape(sc.shape)
        return jnp.einsum('bhqrk,bhrkd->bhqd', p.astype(vr.dtype), vr)

    o = lax.map(row_block, jnp.arange(rows))
    o = jnp.transpose(o, (1, 0, 3, 2, 4)).reshape(b, s, D_MODEL)
    return o @ w_o


def banded_attention(q, k, v, radius, slope_dist):
    n, h, l, dh = q.shape
    nb = -(-l // BAND_BLOCK)
    lp = nb * BAND_BLOCK
    qb = jnp.pad(q, ((0, 0), (0, 0), (0, lp - l), (0, 0))).reshape(n, h, nb, BAND_BLOCK, dh)

    def key_blocks(t):
        tp = jnp.pad(t, ((0, 0), (0, 0), (radius, lp - l + BAND_BLOCK - radius), (0, 0)))
        tp = tp.reshape(n, h, nb + 1, BAND_BLOCK, dh)
        return jnp.concatenate([tp[:, :, :-1], tp[:, :, 1:]], axis=3)

    kb, vb = key_blocks(k), key_blocks(v)
    qi = jnp.arange(lp).reshape(nb, BAND_BLOCK)
    kj = jnp.arange(nb)[:, None] * BAND_BLOCK - radius + jnp.arange(2 * BAND_BLOCK)[None, :]
    dist = jnp.abs(qi[:, :, None] - kj[:, None, :])
    valid = (dist <= radius) & (kj[:, None, :] >= 0) & (kj[:, None, :] < l)
    sc = jnp.einsum('nhbqd,nhbkd->nhbqk', qb, kb).astype(jnp.float32)
    sc = sc - slope_dist[None, :, None, None, None] * dist.astype(jnp.float32)
    sc = jnp.where(valid, sc, NEG_INF)
    lse = jax.nn.logsumexp(sc, axis=-1)
    p = jnp.exp(sc - lse[..., None])
    o = jnp.einsum('nhbqk,nhbkd->nhbqd', p.astype(vb.dtype), vb)
    return o.reshape(n, h, lp, dh)[:, :, :l], lse.reshape(n, h, lp)[:, :, :l]


def dilated_attention(x, w_qkv, w_o):
    b, s, _ = x.shape
    qkv = (x @ w_qkv).reshape(b, s, N_GROUPS, 3, N_HEADS, HEAD_DIM)
    slopes = alibi_slopes(N_HEADS)
    outs, lses = [], []
    for g, (window, dil) in enumerate(DIL_GROUPS):
        radius = window // (2 * dil)
        l = s // dil

        def to_sub(t):
            t = jnp.transpose(t.reshape(b, l, dil, N_HEADS, HEAD_DIM), (0, 2, 3, 1, 4))
            return t.reshape(b * dil, N_HEADS, l, HEAD_DIM)

        q, k, v = (to_sub(qkv[:, :, g, i]) for i in range(3))
        o, lse = banded_attention(q * HEAD_DIM ** -0.5, k, v, radius, slopes * dil)
        o = jnp.transpose(o.reshape(b, dil, N_HEADS, l, HEAD_DIM), (0, 3, 1, 2, 4)).reshape(b, s, N_HEADS, HEAD_DIM)
        lse = jnp.transpose(lse.reshape(b, dil, N_HEADS, l), (0, 3, 1, 2)).reshape(b, s, N_HEADS)
        outs.append(o)
        lses.append(lse)
    alpha = jax.nn.softmax(jnp.stack(lses, axis=0), axis=0)
    o = jnp.einsum('gbsh,gbshd->bshd', alpha, jnp.stack(outs, axis=0).astype(jnp.float32)).astype(x.dtype)
    return o.reshape(b, s, D_MODEL) @ w_o


def setup_inputs(seed: int = 0) -> dict:
    key = jax.random.key(seed)
    ks = jax.random.split(key, 14)
    d = D_MODEL

    def w(k, shape, fan_in):
        return jax.random.normal(k, shape, jnp.float32) * fan_in ** -0.5

    def gain(k):
        return 1.0 + 0.02 * jax.random.normal(k, (DEPTH, d), jnp.float32)

    return {
        "x": jax.random.normal(ks[0], (BATCH, SEQ, d), jnp.float32),
        "norm_mix_pre": gain(ks[1]),
        "norm_mix_post": gain(ks[2]),
        "norm_ffn_pre": gain(ks[3]),
        "norm_ffn_post": gain(ks[4]),
        "na_w_qkv": w(ks[5], (N_A_LAYERS, d, 3 * d), d),
        "na_w_o": w(ks[6], (N_A_LAYERS, d, d), d),
        "na_rpb": 0.5 * jax.random.normal(ks[7], (N_A_LAYERS, N_HEADS, 2 * NA_ROWS - 1, 2 * NA_COLS - 1), jnp.float32),
        "dil_w_qkv": w(ks[8], (N_B_LAYERS, d, N_GROUPS * 3 * d), d),
        "dil_w_o": w(ks[9], (N_B_LAYERS, d, d), d),
        "ffn_w_gate": w(ks[10], (DEPTH, d, D_FF), d),
        "ffn_w_up": w(ks[11], (DEPTH, d, D_FF), d),
        "ffn_w_down": w(ks[12], (DEPTH, D_FF, d), D_FF),
    }


def reference(x, norm_mix_pre, norm_mix_post, norm_ffn_pre, norm_ffn_post, na_w_qkv, na_w_o, na_rpb,
              dil_w_qkv, dil_w_o, ffn_w_gate, ffn_w_up, ffn_w_down):
    for layer in range(DEPTH):
        j = layer // N_MIXERS
        h = rms_norm(x, norm_mix_pre[layer])
        if layer % N_MIXERS == 0:
            h = neighbourhood_attention(h, na_w_qkv[j], na_w_o[j], na_rpb[j])
        else:
            h = dilated_attention(h, dil_w_qkv[j], dil_w_o[j])
        x = x + rms_norm(h, norm_mix_post[layer])
        h = rms_norm(x, norm_ffn_pre[layer])
        x = x + rms_norm(swiglu(h, ffn_w_gate[layer], ffn_w_up[layer], ffn_w_down[layer]), norm_ffn_post[layer])
    return x
```

```cpp
#include <hip/hip_runtime.h>
#include <hip/hip_cooperative_groups.h>
#include <cstdio>
#include <cstdint>
namespace cg = cooperative_groups;
namespace pg8 {
#define PG8_LAS __attribute__((address_space(3)))
typedef unsigned short bf16_t;
typedef short bf16x8 __attribute__((ext_vector_type(8)));
typedef float f32x4 __attribute__((ext_vector_type(4)));
typedef unsigned u32x4 __attribute__((ext_vector_type(4)));
constexpr int BM = 256, BK = 64, HALF = 128, HTB = HALF * BK * 2  , STAGE_BYTES = 8 * HTB, NXCD = 8, WGM = 8;

__host__ __device__ __forceinline__ int lds_byte(int r, int c) { const int st = (r >> 4) * 2 + (c >> 5), rr = r & 15, cc = c & 31, ob = rr * 64 + cc * 2; return st * 1024 + (ob ^ (((ob >> 9) & 1) << 5)); }
__host__ __device__ __forceinline__ void stage_rc(int b, int& R, int& C) { const int st = b / 1024, sb = b % 1024, swz = sb ^ (((sb >> 9) & 1) << 5); R = (st >> 1) * 16 + swz / 64; C = (st & 1) * 32 + (swz % 64) / 2; }
__host__ __device__ __forceinline__ int perm32(int rho) { const int n = rho >> 4, i = rho & 15; return 8 * (i >> 2) + 4 * n + (i & 3); }

struct Unit { int pm, pn; };
struct Gemm { const bf16_t* A; const bf16_t* Bt; int M, N, K; };

struct StaticOrder {
    int nM, nN, nwg, G, c;
    __host__ __device__ void init(int M, int N, int G_, int c_) { nM = M / BM; nN = N / BM; nwg = nM * nN; G = G_; c = c_; }
    __host__ __device__ bool next(int i, Unit& u) const {
        const long L = (long)i * G + c; if (L >= nwg) return false;
        int wgid = (int)L; { const int q = nwg / NXCD, r = nwg % NXCD, xcd = wgid % NXCD, off = wgid / NXCD; wgid = (xcd < r ? xcd * (q + 1) : r * (q + 1) + (xcd - r) * q) + off; }
        const int nig = WGM * nN, gid = wgid / nig, fm = gid * WGM, gsz = (nM - fm) < WGM ? (nM - fm) : WGM;
        u.pm = fm + ((wgid % nig) % gsz); u.pn = (wgid % nig) / gsz; return true;
    }
    __device__ __forceinline__ void a_ready(const Unit&) const {}
    __device__ __forceinline__ void done(const Unit&) const {}
};
__device__ __forceinline__ unsigned cvt_pk_bf16(float lo, float hi) { unsigned r; asm volatile("v_cvt_pk_bf16_f32 %0, %1, %2" : "=v"(r) : "v"(lo), "v"(hi)); return r; }
typedef float f32x2 __attribute__((ext_vector_type(2)));
struct EpiQKV {
    static constexpr bool PERM = true, AFTER_DRAIN = false;
    bf16_t* O; int ldc;
    __device__ __forceinline__ void operator()(const f32x4 (&acc)[2][2][4][2], const Unit& u, int wr, int wc, int fr, int fq) const {
        const int row0 = u.pm * BM + wr * 64 + fr, col0 = u.pn * BM + wc * 32 + 8 * fq;
        const float sc = (u.pn < 4) ? 0.125f : 1.0f;
#pragma unroll
        for (int ai = 0; ai < 2; ++ai)
#pragma unroll
            for (int m = 0; m < 4; ++m) { bf16_t* rowp = O + (size_t)(row0 + ai * HALF + m * 16) * ldc + col0;
#pragma unroll
                for (int bj = 0; bj < 2; ++bj) { const f32x4 v0 = acc[ai][bj][m][0] * sc, v1 = acc[ai][bj][m][1] * sc;
                    u32x4 w; w.x = cvt_pk_bf16(v0[0], v0[1]); w.y = cvt_pk_bf16(v0[2], v0[3]); w.z = cvt_pk_bf16(v1[0], v1[1]); w.w = cvt_pk_bf16(v1[2], v1[3]);
                    *(u32x4*)(rowp + bj * HALF) = w; } }
    }
};
__device__ __forceinline__ float silu_mul(float g, float u) { return g * __builtin_amdgcn_rcpf(1.0f + __builtin_amdgcn_exp2f(-1.4426950408889634f * g)) * u; }
struct EpiSwiGLU {
    static constexpr bool PERM = true, AFTER_DRAIN = false;
    bf16_t* O; int ldc;
    __device__ __forceinline__ void operator()(const f32x4 (&acc)[2][2][4][2], const Unit& u, int wr, int wc, int fr, int fq) const {
        const int row0 = u.pm * BM + wr * 64 + fr, col0 = u.pn * HALF + wc * 32 + 8 * fq;
#pragma unroll
        for (int ai = 0; ai < 2; ++ai)
#pragma unroll
            for (int m = 0; m < 4; ++m) { bf16_t* rowp = O + (size_t)(row0 + ai * HALF + m * 16) * ldc + col0;
                const f32x4 g0 = acc[ai][0][m][0], g1 = acc[ai][0][m][1], u0 = acc[ai][1][m][0], u1 = acc[ai][1][m][1];
                u32x4 w; w.x = cvt_pk_bf16(silu_mul(g0[0], u0[0]), silu_mul(g0[1], u0[1])); w.y = cvt_pk_bf16(silu_mul(g0[2], u0[2]), silu_mul(g0[3], u0[3]));
                w.z = cvt_pk_bf16(silu_mul(g1[0], u1[0]), silu_mul(g1[1], u1[1])); w.w = cvt_pk_bf16(silu_mul(g1[2], u1[2]), silu_mul(g1[3], u1[3]));
                *(u32x4*)rowp = w; }
    }
};
struct EpiF32 {
    static constexpr bool PERM = false, AFTER_DRAIN = false;
    float* O; int ldc;
    __device__ __forceinline__ void operator()(const f32x4 (&acc)[2][2][4][2], const Unit& u, int wr, int wc, int fr, int fq) const {
        const int row0 = u.pm * BM + wr * 64 + fr, col0 = u.pn * BM + wc * 32 + 4 * fq;
#pragma unroll
        for (int ai = 0; ai < 2; ++ai)
#pragma unroll
            for (int m = 0; m < 4; ++m) { float* rowp = O + (size_t)(row0 + ai * HALF + m * 16) * ldc + col0;
#pragma unroll
                for (int bj = 0; bj < 2; ++bj)
#pragma unroll
                    for (int n = 0; n < 2; ++n) *(f32x4*)(rowp + bj * HALF + n * 16) = acc[ai][bj][m][n]; }
    }
};

template <class Epi, class Sched, bool ALIGN_EPI = false, bool SP2 = false>
__device__ __forceinline__ void gemm_phase(PG8_LAS unsigned char* lds, const Gemm g, const Sched& S, const Epi& E) {
    int tid_ = threadIdx.x; asm volatile("" : "+v"(tid_));
    const int tid = tid_, wid = __builtin_amdgcn_readfirstlane(tid >> 6), lane = tid & 63, wr = wid >> 2, wc = wid & 3, fr = lane & 15, fq = lane >> 4;
    const int K = g.K, nt = K / BK;
    unsigned voffA[2], voffB[2];
#pragma unroll
    for (int i = 0; i < 2; ++i) { int R, C; stage_rc(tid * 16 + i * 8192, R, C); const int Rb = Epi::PERM ? ((R & ~31) + perm32(R & 31)) : R;
        voffA[i] = (unsigned)(R * K + C) * 2u; voffB[i] = (unsigned)(Rb * K + C) * 2u; }
    const size_t kstep = (size_t)(BK * 2);
    const size_t hstep = (size_t)HALF * K * 2;
    const size_t tstep = 2 * hstep;
    const unsigned ldsw = (unsigned)wid * 1024u;
    const int aoff = lds_byte(wr * 64 + fr, fq * 8), boff = lds_byte(wc * 32 + fr, fq * 8);
#define PG8_SA(b, h) (((b) * 2 + (h)) * HTB)
#define PG8_SB(b, h) ((4 + (b) * 2 + (h)) * HTB)
#define PG8_STAGE(bufoff, gbase, voff) do { _Pragma("unroll") for (int _i = 0; _i < 2; ++_i) \
        __builtin_amdgcn_global_load_lds((const unsigned*)((const char*)(gbase) + (voff)[_i]), (PG8_LAS unsigned*)(lds + (bufoff) + ldsw + _i * 8192), 16, 0, 0); } while (0)
#define PG8_LDA(dst, b, h) do { _Pragma("unroll") for (int m = 0; m < 4; ++m) _Pragma("unroll") for (int k = 0; k < 2; ++k) dst[m][k] = *(const PG8_LAS bf16x8*)(lds + PG8_SA(b, h) + aoff + m * 2048 + k * 1024); } while (0)
#define PG8_LDB(dst, b, h) do { _Pragma("unroll") for (int n = 0; n < 2; ++n) _Pragma("unroll") for (int k = 0; k < 2; ++k) dst[n][k] = *(const PG8_LAS bf16x8*)(lds + PG8_SB(b, h) + boff + n * 2048 + k * 1024); } while (0)
#define PG8_MMA(ai, bj, At, Bt) do { __builtin_amdgcn_s_setprio(1); _Pragma("unroll") for (int m = 0; m < 4; ++m) _Pragma("unroll") for (int n = 0; n < 2; ++n) _Pragma("unroll") for (int k = 0; k < 2; ++k) \
        acc[ai][bj][m][n] = __builtin_amdgcn_mfma_f32_16x16x32_bf16(Bt[n][k], At[m][k], acc[ai][bj][m][n], 0, 0, 0); __builtin_amdgcn_s_setprio(0); } while (0)
#define PG8_WAIT_V(n) asm volatile("s_waitcnt vmcnt(" #n ")" ::: "memory")
#define PG8_WAIT_L(n) asm volatile("s_waitcnt lgkmcnt(" #n ")" ::: "memory")
#define PG8_BAR __builtin_amdgcn_s_barrier()
#define PG8_SCHED __builtin_amdgcn_sched_barrier(0)
    Unit cur, nxt; int ui = 0;
    if (!S.next(0, cur)) return;
    f32x4 acc[2][2][4][2];
#pragma unroll
    for (int a = 0; a < 2; ++a)
#pragma unroll
        for (int b = 0; b < 2; ++b)
#pragma unroll
            for (int m = 0; m < 4; ++m)
#pragma unroll
                for (int n = 0; n < 2; ++n) acc[a][b][m][n] = (f32x4){0.f, 0.f, 0.f, 0.f};
    bf16x8 At[4][2], B0[2][2], B1[2][2];
    const char* cA = (const char*)g.A + (size_t)cur.pm * tstep; const char* cB = (const char*)g.Bt + (size_t)cur.pn * tstep;
    S.a_ready(cur);
    if constexpr (SP2) {
        PG8_STAGE(PG8_SB(0, 0), cB, voffB); PG8_STAGE(PG8_SB(0, 1), cB + hstep, voffB); PG8_STAGE(PG8_SA(0, 0), cA, voffA); PG8_STAGE(PG8_SA(0, 1), cA + hstep, voffA);
        if (wr == 1) PG8_BAR;
        PG8_WAIT_V(2); PG8_BAR;
        PG8_STAGE(PG8_SB(1, 0), cB + kstep, voffB); PG8_STAGE(PG8_SA(1, 0), cA + kstep, voffA); PG8_STAGE(PG8_SB(1, 1), cB + hstep + kstep, voffB);
        PG8_WAIT_V(6); PG8_BAR;
    } else {
        PG8_STAGE(PG8_SB(0, 0), cB, voffB); PG8_STAGE(PG8_SA(0, 0), cA, voffA); PG8_STAGE(PG8_SB(0, 1), cB + hstep, voffB); PG8_STAGE(PG8_SA(0, 1), cA + hstep, voffA);
        if (wr == 1) PG8_BAR;
        PG8_WAIT_V(4); PG8_BAR;
        PG8_STAGE(PG8_SB(1, 0), cB + kstep, voffB); PG8_STAGE(PG8_SA(1, 0), cA + kstep, voffA); PG8_STAGE(PG8_SB(1, 1), cB + hstep + kstep, voffB);
        PG8_WAIT_V(6); PG8_BAR;
    }
    for (;;) {
        const bool has_next = S.next(ui + 1, nxt);
        const char* nA = has_next ? (const char*)g.A + (size_t)nxt.pm * tstep : cA; const char* nB = has_next ? (const char*)g.Bt + (size_t)nxt.pn * tstep : cB;
        for (int t = 0; t < nt; t += 2) {
            const bool last = (t == nt - 2);
            const char* a1 = cA + (size_t)(t + 1) * kstep;
            const char* a2 = last ? nA : cA + (size_t)(t + 2) * kstep; const char* b2 = last ? nB : cB + (size_t)(t + 2) * kstep;
            const char* a3 = a2 + kstep; const char* b3 = b2 + kstep;
            if (last && has_next) S.a_ready(nxt);
            if constexpr (SP2) {
            PG8_LDB(B0, 0, 0); PG8_LDB(B1, 0, 1); PG8_SCHED; PG8_LDA(At, 0, 0); PG8_STAGE(PG8_SA(1, 1), a1 + hstep, voffA);
            PG8_WAIT_V(8); PG8_WAIT_L(0); PG8_BAR; PG8_MMA(0, 0, At, B0); PG8_MMA(0, 1, At, B1); PG8_BAR; PG8_SCHED;
            PG8_LDA(At, 0, 1); PG8_STAGE(PG8_SB(0, 0), b2, voffB); PG8_STAGE(PG8_SB(0, 1), b2 + hstep, voffB); PG8_STAGE(PG8_SA(0, 0), a2, voffA);
            PG8_WAIT_V(8); PG8_WAIT_L(0); PG8_BAR; PG8_MMA(1, 0, At, B0); PG8_MMA(1, 1, At, B1); PG8_BAR; PG8_SCHED;
            PG8_LDB(B0, 1, 0); PG8_LDB(B1, 1, 1); PG8_SCHED; PG8_LDA(At, 1, 0); PG8_STAGE(PG8_SA(0, 1), a2 + hstep, voffA);
            PG8_WAIT_V(8); PG8_WAIT_L(0); PG8_BAR; PG8_MMA(0, 0, At, B0); PG8_MMA(0, 1, At, B1); PG8_BAR; PG8_SCHED;
            PG8_LDA(At, 1, 1); PG8_STAGE(PG8_SB(1, 0), b3, voffB); PG8_STAGE(PG8_SB(1, 1), b3 + hstep, voffB); PG8_STAGE(PG8_SA(1, 0), a3, voffA);
            PG8_WAIT_V(8); PG8_WAIT_L(0); PG8_BAR; PG8_MMA(1, 0, At, B0); PG8_MMA(1, 1, At, B1); PG8_BAR; PG8_SCHED;
            } else {
            PG8_LDB(B0, 0, 0); PG8_SCHED; PG8_LDA(At, 0, 0); PG8_STAGE(PG8_SA(1, 1), a1 + hstep, voffA);
            PG8_WAIT_L(8); PG8_BAR; PG8_WAIT_L(0); PG8_MMA(0, 0, At, B0); PG8_BAR; PG8_SCHED;
            PG8_LDB(B1, 0, 1); PG8_STAGE(PG8_SB(0, 0), b2, voffB);
            PG8_BAR; PG8_WAIT_L(0); PG8_MMA(0, 1, At, B1); PG8_BAR;
            PG8_LDA(At, 0, 1); PG8_STAGE(PG8_SA(0, 0), a2, voffA);
            PG8_BAR; PG8_WAIT_L(0); PG8_MMA(1, 0, At, B0); PG8_BAR; PG8_SCHED;
            PG8_STAGE(PG8_SB(0, 1), b2 + hstep, voffB);
            PG8_WAIT_V(6); PG8_BAR; PG8_MMA(1, 1, At, B1); PG8_BAR;
            PG8_LDB(B0, 1, 0); PG8_SCHED; PG8_LDA(At, 1, 0); PG8_STAGE(PG8_SA(0, 1), a2 + hstep, voffA);
            PG8_WAIT_L(8); PG8_BAR; PG8_WAIT_L(0); PG8_MMA(0, 0, At, B0); PG8_BAR; PG8_SCHED;
            PG8_LDB(B1, 1, 1); PG8_STAGE(PG8_SB(1, 0), b3, voffB);
            PG8_BAR; PG8_WAIT_L(0); PG8_MMA(0, 1, At, B1); PG8_BAR;
            PG8_LDA(At, 1, 1); PG8_STAGE(PG8_SA(1, 0), a3, voffA);
            PG8_BAR; PG8_WAIT_L(0); PG8_MMA(1, 0, At, B0); PG8_BAR; PG8_SCHED;
            PG8_STAGE(PG8_SB(1, 1), b3 + hstep, voffB);
            PG8_WAIT_V(6); PG8_BAR; PG8_MMA(1, 1, At, B1); PG8_BAR;
            }
        }
        if constexpr (ALIGN_EPI) { if (wr == 0) PG8_BAR; }
        if constexpr (!Epi::AFTER_DRAIN) { E(acc, cur, wr, wc, fr, fq); S.done(cur); }
        if (!has_next) break;
#pragma unroll
        for (int a = 0; a < 2; ++a)
#pragma unroll
            for (int b = 0; b < 2; ++b)
#pragma unroll
                for (int m = 0; m < 4; ++m)
#pragma unroll
                    for (int n = 0; n < 2; ++n) acc[a][b][m][n] = (f32x4){0.f, 0.f, 0.f, 0.f};
        cur = nxt; cA = nA; cB = nB; ++ui;
        if constexpr (ALIGN_EPI) { if (wr == 1) PG8_BAR; }
    }
    PG8_WAIT_V(0);
    if constexpr (!ALIGN_EPI) { if (wr == 0) PG8_BAR; }
    PG8_BAR;
    if constexpr (Epi::AFTER_DRAIN) { E.fused(acc, cur, wr, wc, fr, fq, lds, wid, lane); S.done(cur); }
#undef PG8_SA
#undef PG8_SB
#undef PG8_STAGE
#undef PG8_LDA
#undef PG8_LDB
#undef PG8_MMA
#undef PG8_WAIT_V
#undef PG8_WAIT_L
#undef PG8_BAR
#undef PG8_SCHED
}
}

constexpr int NWAVES = 8, NTHREADS = 512;
constexpr int BATCH = 8, SEQ = 2048, DM = 1024, NH = 16, HD = 64, FF = 2816, DEPTH_ = 2;
constexpr int M = BATCH * SEQ;
constexpr int GRID_W = 64, GRID_ROWS = SEQ / GRID_W;
constexpr float RMS_EPS = 1e-6f, LOG2E = 1.4426950408889634f, NEG_BIG = -1e30f;
constexpr size_t MiB = 1u << 20;
constexpr size_t WS_W = 0;
constexpr size_t W_QKV = 0;
constexpr size_t W0_O = 6 * MiB, W0_GU = 8 * MiB, W0_DN = 19 * MiB;
constexpr size_t W1_O = 18 * MiB, W1_GU = 20 * MiB, W1_DN = 31 * MiB;
constexpr size_t WS_L = 38 * MiB;
constexpr size_t WS_XN = 40 * MiB;
constexpr size_t WS_R1 = 72 * MiB;
constexpr size_t WS_R2 = 168 * MiB;
constexpr size_t WS_END = 232 * MiB;
constexpr int LDS_BYTES = 147456;
#define GAS __attribute__((address_space(1)))
#define LAS __attribute__((address_space(3)))
typedef unsigned short bf16;
typedef unsigned v4u __attribute__((ext_vector_type(4)));
typedef unsigned v2u __attribute__((ext_vector_type(2)));
typedef float f32x4 __attribute__((ext_vector_type(4)));
typedef short bf16x8 __attribute__((ext_vector_type(8)));
typedef short bf16x4 __attribute__((ext_vector_type(4)));
#define LDS_WAIT() asm volatile("s_waitcnt lgkmcnt(0)" ::: "memory")
__device__ __forceinline__ unsigned f2bf(float f) { unsigned u = __builtin_bit_cast(unsigned, f); return (u + 0x7fffu + ((u >> 16) & 1u)) >> 16; }
__device__ __forceinline__ unsigned pk2(float lo, float hi) { return f2bf(lo) | (f2bf(hi) << 16); }
__device__ __forceinline__ float wave_sum(float v) {
#pragma unroll
    for (int o = 1; o < 64; o <<= 1) v += __shfl_xor(v, o);
    return v;
}
__device__ __forceinline__ void transpose_item(const float* W, int ldn, int K, int k0, int c0, bf16* WT, int drow0, LAS float* scr, int lane) {
#pragma unroll 8
    for (int i = 0; i < 32; ++i) { const int kk = 2 * i + (lane >> 5); scr[kk * 33 + (lane & 31)] = W[(size_t)(k0 + kk) * ldn + c0 + (lane & 31)]; }
    LDS_WAIT(); asm volatile("" ::: "memory");
    const int c = lane & 7;
#pragma unroll
    for (int j = 0; j < 4; ++j) { const int n = (lane >> 3) + 8 * j; const LAS float* s = scr + (8 * c) * 33 + n;
        v4u o; o.x = pk2(s[0 * 33], s[1 * 33]); o.y = pk2(s[2 * 33], s[3 * 33]); o.z = pk2(s[4 * 33], s[5 * 33]); o.w = pk2(s[6 * 33], s[7 * 33]);
        *(GAS v4u*)(WT + (size_t)(drow0 + n) * K + k0 + 8 * c) = o; }
    LDS_WAIT(); asm volatile("" ::: "memory");
}
__device__ __forceinline__ void convert_weights(int layer, const float* wqkv, int nqkv, const float* wo, const float* wg, const float* wu, const float* wd,
                                                unsigned char* ws, LAS float* scr, int gw, int ngw, int lane) {
    bf16* Tqkv = (bf16*)(ws + WS_W + W_QKV);
    bf16* To = (bf16*)(ws + WS_W + (layer == 0 ? W0_O : W1_O));
    bf16* Tgu = (bf16*)(ws + WS_W + (layer == 0 ? W0_GU : W1_GU));
    bf16* Tdn = (bf16*)(ws + WS_W + (layer == 0 ? W0_DN : W1_DN));
    const int I_QKV = (DM / 64) * (nqkv / 32), I_O = (DM / 64) * (DM / 32), I_G = (DM / 64) * (FF / 32), I_D = (FF / 64) * (DM / 32);
    const int NIT = I_QKV + I_O + 2 * I_G + I_D;
    for (int it = gw; it < NIT; it += ngw) {
        int r = it;
        if (r < I_QKV) { const int nb = nqkv / 32, kb = r / nb, cb = r % nb; transpose_item(wqkv, nqkv, DM, 64 * kb, 32 * cb, Tqkv, 32 * cb, scr, lane); continue; } r -= I_QKV;
        if (r < I_O) { const int nb = DM / 32, kb = r / nb, cb = r % nb; transpose_item(wo, DM, DM, 64 * kb, 32 * cb, To, 32 * cb, scr, lane); continue; } r -= I_O;
        if (r < 2 * I_G) { const int up = r >= I_G; if (up) r -= I_G; const int nb = FF / 32, kb = r / nb, cb = r % nb, c0 = 32 * cb;
            transpose_item(up ? wu : wg, FF, DM, 64 * kb, c0, Tgu, (c0 >> 7) * 256 + (up ? 128 : 0) + (c0 & 127), scr, lane); continue; } r -= 2 * I_G;
        { const int nb = DM / 32, kb = r / nb, cb = r % nb; transpose_item(wd, DM, FF, 64 * kb, 32 * cb, Tdn, 32 * cb, scr, lane); }
    }
}
__device__ __forceinline__ void norm_rows(const float* x, const float* g, bf16* xn, int gw, int ngw, int lane) {
    f32x4 gv[4];
#pragma unroll
    for (int j = 0; j < 4; ++j) gv[j] = ((const f32x4*)g)[lane + 64 * j];
    for (int m = gw; m < M; m += ngw) {
        const f32x4* xr = (const f32x4*)(x + (size_t)m * DM) + lane;
        f32x4 v[4]; float s = 0.f;
#pragma unroll
        for (int j = 0; j < 4; ++j) { v[j] = xr[64 * j]; s += (v[j].x * v[j].x + v[j].y * v[j].y) + (v[j].z * v[j].z + v[j].w * v[j].w); }
        const float r = 1.0f / sqrtf(wave_sum(s) * (1.0f / DM) + RMS_EPS);
        v2u* o8 = (v2u*)(xn + (size_t)m * DM) + lane;
#pragma unroll
        for (int j = 0; j < 4; ++j) { const f32x4 y = v[j] * r * gv[j]; v2u w; w.x = pk2(y.x, y.y); w.y = pk2(y.z, y.w); o8[64 * j] = w; }
    }
}
__device__ __forceinline__ void resid_norm_rows(const float* h, const float* gpost, const float* xin, float* xout, const float* gnext, bf16* xn, int gw, int ngw, int lane) {
    f32x4 gp[4], gn[4];
#pragma unroll
    for (int j = 0; j < 4; ++j) { gp[j] = ((const f32x4*)gpost)[lane + 64 * j]; gn[j] = gnext ? ((const f32x4*)gnext)[lane + 64 * j] : (f32x4){0.f, 0.f, 0.f, 0.f}; }
    for (int m = gw; m < M; m += ngw) {
        const f32x4* hr = (const f32x4*)(h + (size_t)m * DM) + lane;
        const f32x4* xr = (const f32x4*)(xin + (size_t)m * DM) + lane;
        f32x4 v[4], xv[4]; float s = 0.f;
#pragma unroll
        for (int j = 0; j < 4; ++j) { v[j] = hr[64 * j]; xv[j] = xr[64 * j]; s += (v[j].x * v[j].x + v[j].y * v[j].y) + (v[j].z * v[j].z + v[j].w * v[j].w); }
        const float r = 1.0f / sqrtf(wave_sum(s) * (1.0f / DM) + RMS_EPS);
        f32x4* xo = (f32x4*)(xout + (size_t)m * DM) + lane; float s2 = 0.f;
#pragma unroll
        for (int j = 0; j < 4; ++j) { xv[j] = xv[j] + v[j] * r * gp[j]; xo[64 * j] = xv[j]; s2 += (xv[j].x * xv[j].x + xv[j].y * xv[j].y) + (xv[j].z * xv[j].z + xv[j].w * xv[j].w); }
        if (gnext) {
            const float r2 = 1.0f / sqrtf(wave_sum(s2) * (1.0f / DM) + RMS_EPS);
            v2u* o8 = (v2u*)(xn + (size_t)m * DM) + lane;
#pragma unroll
            for (int j = 0; j < 4; ++j) { const f32x4 y = xv[j] * r2 * gn[j]; v2u w; w.x = pk2(y.x, y.y); w.y = pk2(y.z, y.w); o8[64 * j] = w; }
        }
    }
}
__device__ __forceinline__ f32x4 mfma16(bf16x8 a, bf16x8 b, f32x4 c) { return __builtin_amdgcn_mfma_f32_16x16x32_bf16(a, b, c, 0, 0, 0); }
__device__ __forceinline__ unsigned cvtpk(float lo, float hi) { return pg8::cvt_pk_bf16(lo, hi); }
__device__ __forceinline__ void vt_write8(LAS unsigned* dst, int pitch_dw, v4u a, v4u b) {
#pragma unroll
    for (int w = 0; w < 4; ++w) { dst[(2 * w) * pitch_dw] = (a[w] & 0xffffu) | (b[w] << 16); dst[(2 * w + 1) * pitch_dw] = (a[w] >> 16) | (b[w] & 0xffff0000u); }
}
__device__ __forceinline__ void na_attn_phase(LAS unsigned char* lds, const bf16* QKV, const float* rpb, bf16* O, int vcu, int G, int tid) {
    constexpr int KP = 520, LDQ = 3 * DM;
    LAS bf16* Vt = (LAS bf16*)lds;
    LAS float* tbl = (LAS float*)(lds + 2 * 64 * KP * 2);
    const int lane = tid & 63, wid = __builtin_amdgcn_readfirstlane(tid >> 6), c16 = lane & 15, g = lane >> 4;
    const int hh = wid >> 2, j = wid & 3;
    const int w0 = (j == 0) ? 0 : (j == 1) ? 8 : (j == 2) ? 24 : 32;
    for (int u = vcu; u < BATCH * GRID_ROWS * 8; u += G) {
        const int hp = u & 7, i = (u >> 3) & 31, b = u >> 8;
        const int rs = min(max(i - 4, 0), GRID_ROWS - 8);
        const int h = 2 * hp + hh;
        const size_t tb = (size_t)b * SEQ + rs * GRID_W;
        __syncthreads();
#pragma unroll 2
        for (int it = 0; it < 8; ++it) {
            const int p = it * 2 + (tid >> 8), kp = tid & 255;
            const bf16* src = QKV + (tb + 2 * kp) * LDQ + 2 * DM + hp * 128 + p * 8;
            const v4u a = *(const v4u*)src, bb = *(const v4u*)(src + LDQ);
            vt_write8((LAS unsigned*)(Vt + (p * 8) * KP + 2 * kp), KP / 2, a, bb);
        }
        for (int idx = tid; idx < 2 * 465; idx += NTHREADS) { const int h2 = idx >= 465, k = idx - h2 * 465; tbl[h2 * 512 + k] = rpb[(2 * hp + h2) * 465 + k] * LOG2E; }
        const size_t qtok = (size_t)b * SEQ + i * GRID_W + 16 * j + c16;
        const bf16* qp = QKV + qtok * LDQ + h * HD + g * 8;
        const bf16x8 q0 = *(const bf16x8*)qp, q1 = *(const bf16x8*)(qp + 32);
        f32x4 s[16];
#pragma unroll
        for (int t = 0; t < 16; ++t) {
            const bf16* kp_ = QKV + (tb + (t >> 1) * GRID_W + w0 + 16 * (t & 1) + c16) * LDQ + DM + h * HD + g * 8;
            const bf16x8 k0 = *(const bf16x8*)kp_, k1 = *(const bf16x8*)(kp_ + 32);
            s[t] = mfma16(k0, q0, (f32x4){0.f, 0.f, 0.f, 0.f}); s[t] = mfma16(k1, q1, s[t]);
        }
        __syncthreads();
        const int qc = 16 * j + c16, cs = min(max(qc - 8, 0), GRID_W - 16);
        const LAS float* tb_ = tbl + hh * 512;
        float mx = NEG_BIG;
#pragma unroll
        for (int t = 0; t < 16; ++t) {
            const int brow = (rs + (t >> 1) - i + 7) * 31;
#pragma unroll
            for (int jj = 0; jj < 4; ++jj) {
                const int kc = w0 + 16 * (t & 1) + 4 * g + jj; const bool valid = (kc >= cs) && (kc < cs + 16);
                const int bidx = brow + min(max(kc - qc + 15, 0), 30);
                const float v = valid ? s[t][jj] * LOG2E + tb_[bidx] : NEG_BIG; s[t][jj] = v; mx = fmaxf(mx, v);
            }
        }
        mx = fmaxf(mx, __shfl_xor(mx, 16)); mx = fmaxf(mx, __shfl_xor(mx, 32));
        float l = 0.f;
#pragma unroll
        for (int t = 0; t < 16; ++t)
#pragma unroll
            for (int jj = 0; jj < 4; ++jj) { const float p = __builtin_amdgcn_exp2f(s[t][jj] - mx); s[t][jj] = p; l += p; }
        l += __shfl_xor(l, 16); l += __shfl_xor(l, 32);
        f32x4 o[4];
#pragma unroll
        for (int dt = 0; dt < 4; ++dt) o[dt] = (f32x4){0.f, 0.f, 0.f, 0.f};
#pragma unroll
        for (int c = 0; c < 8; ++c) {
            v4u pw; pw.x = cvtpk(s[2 * c][0], s[2 * c][1]); pw.y = cvtpk(s[2 * c][2], s[2 * c][3]); pw.z = cvtpk(s[2 * c + 1][0], s[2 * c + 1][1]); pw.w = cvtpk(s[2 * c + 1][2], s[2 * c + 1][3]);
            const bf16x8 pf = __builtin_bit_cast(bf16x8, pw);
#pragma unroll
            for (int dt = 0; dt < 4; ++dt) {
                const LAS bf16* vp = Vt + (hh * 64 + dt * 16 + c16) * KP + c * 64 + w0 + 4 * g;
                const v2u lo = *(const LAS v2u*)vp, hi = *(const LAS v2u*)(vp + 16);
                const v4u vv = (v4u){lo.x, lo.y, hi.x, hi.y};
                o[dt] = mfma16(__builtin_bit_cast(bf16x8, vv), pf, o[dt]);
            }
        }
        const float rl = 1.0f / l;
        bf16* op = O + qtok * DM + h * HD + 4 * g;
#pragma unroll
        for (int dt = 0; dt < 4; ++dt) { v2u w; w.x = cvtpk(o[dt][0] * rl, o[dt][1] * rl); w.y = cvtpk(o[dt][2] * rl, o[dt][3] * rl); *(v2u*)(op + dt * 16) = w; }
    }
}
__device__ __forceinline__ void dil_attn_phase(LAS unsigned char* lds, const bf16* QKV, float* Oacc, float* Lacc, bf16* Obf, int gi, int vcu, int G, int tid) {
    constexpr int KP2 = 280, LDQ = 3 * DM;
    LAS bf16* Vt = (LAS bf16*)lds;
    const int lane = tid & 63, wid = __builtin_amdgcn_readfirstlane(tid >> 6), c16 = lane & 15, g = lane >> 4;
    const int dsh = 2 * gi, dil = 1 << dsh, L = SEQ >> dsh, nqb = L >> 7, qsh = 4 - dsh;
    for (int u = vcu; u < 2048; u += G) {
        const int h = u & 15, rest = u >> 4, qb = rest & (nqb - 1), r = (rest >> qsh) & (dil - 1), b = rest >> 4;
        const int kbase = 128 * qb - 80;
        const size_t tb = (size_t)b * SEQ + r;
        __syncthreads();
#pragma unroll
        for (int it = 0; it < 3; ++it) {
            const int idx = it * NTHREADS + tid;
            if (idx < 1088) {
                const int p = idx / 136, kp = idx - p * 136, ma = kbase + 2 * kp, mb = ma + 1;
                v4u a = (v4u){0u, 0u, 0u, 0u}, bb = (v4u){0u, 0u, 0u, 0u};
                if (ma >= 0 && ma < L) a = *(const v4u*)(QKV + (tb + (size_t)ma * dil) * LDQ + 2 * DM + h * HD + p * 8);
                if (mb >= 0 && mb < L) bb = *(const v4u*)(QKV + (tb + (size_t)mb * dil) * LDQ + 2 * DM + h * HD + p * 8);
                vt_write8((LAS unsigned*)(Vt + (p * 8) * KP2 + 2 * kp), KP2 / 2, a, bb);
            }
        }
        const int m0 = 128 * qb + 16 * wid, m = m0 + c16;
        const size_t qtok = tb + (size_t)m * dil;
        const bf16* qp = QKV + qtok * LDQ + h * HD + g * 8;
        const bf16x8 q0 = *(const bf16x8*)qp, q1 = *(const bf16x8*)(qp + 32);
        f32x4 s[10];
#pragma unroll
        for (int t = 0; t < 10; ++t) {
            const int mk = min(max(m0 - 80 + 16 * t + c16, 0), L - 1);
            const bf16* kp_ = QKV + (tb + (size_t)mk * dil) * LDQ + DM + h * HD + g * 8;
            const bf16x8 k0 = *(const bf16x8*)kp_, k1 = *(const bf16x8*)(kp_ + 32);
            s[t] = mfma16(k0, q0, (f32x4){0.f, 0.f, 0.f, 0.f}); s[t] = mfma16(k1, q1, s[t]);
        }
        const float slope2 = __builtin_amdgcn_exp2f(-0.5f * (float)(h + 1)) * (float)dil * LOG2E;
        float mx = NEG_BIG;
#pragma unroll
        for (int t = 0; t < 10; ++t)
#pragma unroll
            for (int jj = 0; jj < 4; ++jj) {
                const int mk = m0 - 80 + 16 * t + 4 * g + jj, dist = abs(m - mk); const bool valid = (dist <= 64) && (mk >= 0) && (mk < L);
                const float v = valid ? s[t][jj] * LOG2E - slope2 * (float)dist : NEG_BIG; s[t][jj] = v; mx = fmaxf(mx, v);
            }
        mx = fmaxf(mx, __shfl_xor(mx, 16)); mx = fmaxf(mx, __shfl_xor(mx, 32));
        float l = 0.f;
#pragma unroll
        for (int t = 0; t < 10; ++t)
#pragma unroll
            for (int jj = 0; jj < 4; ++jj) { const float p = __builtin_amdgcn_exp2f(s[t][jj] - mx); s[t][jj] = p; l += p; }
        l += __shfl_xor(l, 16); l += __shfl_xor(l, 32);
        __syncthreads();
        f32x4 o[4];
#pragma unroll
        for (int dt = 0; dt < 4; ++dt) o[dt] = (f32x4){0.f, 0.f, 0.f, 0.f};
#pragma unroll
        for (int c = 0; c < 5; ++c) {
            v4u pw; pw.x = cvtpk(s[2 * c][0], s[2 * c][1]); pw.y = cvtpk(s[2 * c][2], s[2 * c][3]); pw.z = cvtpk(s[2 * c + 1][0], s[2 * c + 1][1]); pw.w = cvtpk(s[2 * c + 1][2], s[2 * c + 1][3]);
            const bf16x8 pf = __builtin_bit_cast(bf16x8, pw);
#pragma unroll
            for (int dt = 0; dt < 4; ++dt) {
                const LAS bf16* vp = Vt + (dt * 16 + c16) * KP2 + 16 * wid + 32 * c + 4 * g;
                const v2u lo = *(const LAS v2u*)vp, hi = *(const LAS v2u*)(vp + 16);
                const v4u vv = (v4u){lo.x, lo.y, hi.x, hi.y};
                o[dt] = mfma16(__builtin_bit_cast(bf16x8, vv), pf, o[dt]);
            }
        }
        const float lse2 = mx + __builtin_log2f(l);
        float wn = 1.0f / l, wo = 0.f, lnew = lse2;
        float* lp = Lacc + qtok * NH + h;
        if (gi > 0) { const float lo_ = *lp, mm = fmaxf(lo_, lse2); lnew = mm + __builtin_log2f(__builtin_amdgcn_exp2f(lo_ - mm) + __builtin_amdgcn_exp2f(lse2 - mm));
            wo = __builtin_amdgcn_exp2f(lo_ - lnew); wn *= __builtin_amdgcn_exp2f(lse2 - lnew); }
        float* oa = Oacc + qtok * DM + h * HD + 4 * g;
#pragma unroll
        for (int dt = 0; dt < 4; ++dt) {
            f32x4 v = o[dt] * wn;
            if (gi > 0) v += *(const f32x4*)(oa + dt * 16) * wo;
            if (gi < 2) *(f32x4*)(oa + dt * 16) = v;
            else { v2u w; w.x = cvtpk(v[0], v[1]); w.y = cvtpk(v[2], v[3]); *(v2u*)(Obf + qtok * DM + h * HD + 4 * g + dt * 16) = w; }
        }
        if (gi < 2 && g == 0) *lp = lnew;
    }
}
constexpr int N_PHASES = 19;
struct Args { const float* in[13]; float* out; unsigned char* ws; int ph_lo, ph_hi; };
static_assert(sizeof(Args) == 15 * 8 + 8, "Args has no padding");
__global__ void __launch_bounds__(NTHREADS, 2) mk_fwd(Args a) {
    extern __shared__ __attribute__((aligned(16))) unsigned char lds_raw[];
    LAS unsigned char* lds = (LAS unsigned char*)lds_raw;
    cg::grid_group grid = cg::this_grid();
    const int tid0 = threadIdx.x;
    const int G = gridDim.x, bx = blockIdx.x, vcu = (G % 8 == 0) ? (bx % 8) * (G / 8) + bx / 8 : bx;
    const int ngw = G * NWAVES;
    unsigned char* ws = a.ws;
    const float* x = a.in[0];
    bf16* XN = (bf16*)(ws + WS_XN); bf16* R1 = (bf16*)(ws + WS_R1); float* R2 = (float*)(ws + WS_R2); float* LA = (float*)(ws + WS_L);
    for (int ph = a.ph_lo; ph < a.ph_hi; ++ph) {
        int tid = tid0; asm volatile("" : "+v"(tid));
        const int lane = tid & 63, wave = __builtin_amdgcn_readfirstlane(tid >> 6), gw = vcu * NWAVES + wave;
        LAS float* scr = (LAS float*)(lds + wave * 16384);
        const int layer = ph >= 8 ? 1 : 0;
        const bf16* Wqkv = (const bf16*)(ws + WS_W + W_QKV);
        const bf16* Wo = (const bf16*)(ws + WS_W + (layer ? W1_O : W0_O));
        const bf16* Wgu = (const bf16*)(ws + WS_W + (layer ? W1_GU : W0_GU));
        const bf16* Wdn = (const bf16*)(ws + WS_W + (layer ? W1_DN : W0_DN));
        switch (ph) {
        case 0:
            convert_weights(0, a.in[5], 3 * DM, a.in[6], a.in[10], a.in[11], a.in[12], ws, scr, gw, ngw, lane);
            norm_rows(x, a.in[1], XN, gw, ngw, lane);
            break;
        case 1: case 8: case 10: case 12: {
            const int gi = ph == 1 ? 0 : (ph - 8) >> 1;
            pg8::Gemm g{XN, Wqkv + (size_t)gi * 3 * DM * DM, M, 3 * DM, DM}; pg8::StaticOrder S; S.init(M, 3 * DM, G, bx);
            pg8::EpiQKV E{R1, 3 * DM};
            pg8::gemm_phase<pg8::EpiQKV, pg8::StaticOrder, true, true>(lds, g, S, E);
        } break;
        case 2:
            na_attn_phase(lds, R1, a.in[7], XN, vcu, G, tid);
            break;
        case 3: case 14: {
            pg8::Gemm g{XN, Wo, M, DM, DM}; pg8::StaticOrder S; S.init(M, DM, G, bx);
            pg8::EpiF32 E{R2, DM};
            pg8::gemm_phase<pg8::EpiF32, pg8::StaticOrder, true, true>(lds, g, S, E);
        } break;
        case 4: resid_norm_rows(R2, a.in[2], x, a.out, a.in[3], XN, gw, ngw, lane); break;
        case 15: resid_norm_rows(R2, a.in[2] + DM, a.out, a.out, a.in[3] + DM, XN, gw, ngw, lane); break;
        case 5: case 16: {
            pg8::Gemm g{XN, Wgu, M, 2 * FF, DM}; pg8::StaticOrder S; S.init(M, 2 * FF, G, bx);
            pg8::EpiSwiGLU E{R1, FF};
            pg8::gemm_phase<pg8::EpiSwiGLU, pg8::StaticOrder, true, true>(lds, g, S, E);
        } break;
        case 6: case 17: {
            pg8::Gemm g{R1, Wdn, M, DM, FF}; pg8::StaticOrder S; S.init(M, DM, G, bx);
            pg8::EpiF32 E{R2, DM};
            pg8::gemm_phase<pg8::EpiF32, pg8::StaticOrder, true, true>(lds, g, S, E);
        } break;
        case 7:
            resid_norm_rows(R2, a.in[4], a.out, a.out, a.in[1] + DM, XN, gw, ngw, lane);
            convert_weights(1, a.in[8], 9 * DM, a.in[9], a.in[10] + (size_t)DM * FF, a.in[11] + (size_t)DM * FF, a.in[12] + (size_t)DM * FF, ws, scr, gw, ngw, lane);
            break;
        case 9: case 11: case 13:
            dil_attn_phase(lds, R1, R2, LA, XN, (ph - 9) >> 1, vcu, G, tid);
            break;
        case 18: resid_norm_rows(R2, a.in[4] + DM, a.out, a.out, nullptr, nullptr, gw, ngw, lane); break;
        default: break;
        }
        if (ph + 1 < a.ph_hi) grid.sync();
    }
}

extern "C" void kernel_launch(void* const* d_in, const int* in_sizes, int n_in, void* d_out, int out_size, void* d_ws, size_t ws_size, hipStream_t stream) {
    static int grid = 0;
    if (grid == 0) {
        if (n_in != 13 || in_sizes[0] != M * DM || out_size != M * DM || ws_size < WS_END) { fprintf(stderr, "kernel_launch: unexpected shapes / workspace (n_in %d, ws %zu)\n", n_in, ws_size); grid = -1; return; }
        int dev = 0, cus = 0, per_cu = 0;
        if (hipGetDevice(&dev) != hipSuccess || hipDeviceGetAttribute(&cus, hipDeviceAttributeMultiprocessorCount, dev) != hipSuccess) { grid = -1; return; }
        if (hipFuncSetAttribute((const void*)mk_fwd, hipFuncAttributeMaxDynamicSharedMemorySize, LDS_BYTES) != hipSuccess) { fprintf(stderr, "kernel_launch: hipFuncSetAttribute failed\n"); grid = -1; return; }
        if (hipOccupancyMaxActiveBlocksPerMultiprocessor(&per_cu, (const void*)mk_fwd, NTHREADS, LDS_BYTES) != hipSuccess || per_cu < 1) per_cu = 1;
        (void)hipGetLastError();
        grid = cus * per_cu;
    }
    if (grid < 0) return;
    Args a{};
    for (int i = 0; i < 13; ++i) a.in[i] = (const float*)d_in[i];
    a.out = (float*)d_out; a.ws = (unsigned char*)d_ws; a.ph_lo = 0; a.ph_hi = N_PHASES;
    void* args[] = {&a};
    hipError_t e = hipLaunchCooperativeKernel((const void*)mk_fwd, dim3(grid), dim3(NTHREADS), args, LDS_BYTES, stream);
    if (e != hipSuccess) fprintf(stderr, "cooperative launch failed: %s (grid %d)\n", hipGetErrorString(e), grid);
}
```

```cpp
#include <hip/hip_runtime.h>
#include <hip/hip_cooperative_groups.h>
#include <cstdio>
#include <cstdint>
namespace cg = cooperative_groups;
#ifndef REP_GEMM
#define REP_GEMM 1
#endif
#ifndef REP_SYNC
#define REP_SYNC 1
#endif
#ifndef REP_ATTN
#define REP_ATTN 1
#endif
#ifndef REP_EW
#define REP_EW 1
#endif
namespace pg8 {
#define PG8_LAS __attribute__((address_space(3)))
typedef unsigned short bf16_t;
typedef short bf16x8 __attribute__((ext_vector_type(8)));
typedef float f32x4 __attribute__((ext_vector_type(4)));
typedef unsigned u32x4 __attribute__((ext_vector_type(4)));
constexpr int BM = 256, BK = 64, HALF = 128, HTB = HALF * BK * 2  , STAGE_BYTES = 8 * HTB, NXCD = 8, WGM = 8;

__host__ __device__ __forceinline__ int lds_byte(int r, int c) { const int st = (r >> 4) * 2 + (c >> 5), rr = r & 15, cc = c & 31, ob = rr * 64 + cc * 2; return st * 1024 + (ob ^ (((ob >> 9) & 1) << 5)); }
__host__ __device__ __forceinline__ void stage_rc(int b, int& R, int& C) { const int st = b / 1024, sb = b % 1024, swz = sb ^ (((sb >> 9) & 1) << 5); R = (st >> 1) * 16 + swz / 64; C = (st & 1) * 32 + (swz % 64) / 2; }
__host__ __device__ __forceinline__ int perm32(int rho) { const int n = rho >> 4, i = rho & 15; return 8 * (i >> 2) + 4 * n + (i & 3); }

struct Unit { int pm, pn; };
struct Gemm { const bf16_t* A; const bf16_t* Bt; int M, N, K; };

struct StaticOrder {
    int nM, nN, nwg, G, c;
    __host__ __device__ void init(int M, int N, int G_, int c_) { nM = M / BM; nN = N / BM; nwg = nM * nN; G = G_; c = c_; }
    __host__ __device__ bool next(int i, Unit& u) const {
        const long L = (long)i * G + c; if (L >= nwg) return false;
        int wgid = (int)L; { const int q = nwg / NXCD, r = nwg % NXCD, xcd = wgid % NXCD, off = wgid / NXCD; wgid = (xcd < r ? xcd * (q + 1) : r * (q + 1) + (xcd - r) * q) + off; }
        const int nig = WGM * nN, gid = wgid / nig, fm = gid * WGM, gsz = (nM - fm) < WGM ? (nM - fm) : WGM;
        u.pm = fm + ((wgid % nig) % gsz); u.pn = (wgid % nig) / gsz; return true;
    }
    __device__ __forceinline__ void a_ready(const Unit&) const {}
    __device__ __forceinline__ void done(const Unit&) const {}
};
__device__ __forceinline__ unsigned cvt_pk_bf16(float lo, float hi) { unsigned r; asm volatile("v_cvt_pk_bf16_f32 %0, %1, %2" : "=v"(r) : "v"(lo), "v"(hi)); return r; }
typedef float f32x2 __attribute__((ext_vector_type(2)));
struct EpiQKV {
    static constexpr bool PERM = true, AFTER_DRAIN = false;
    bf16_t* O; int ldc;
    __device__ __forceinline__ void operator()(const f32x4 (&acc)[2][2][4][2], const Unit& u, int wr, int wc, int fr, int fq) const {
        const int row0 = u.pm * BM + wr * 64 + fr, col0 = u.pn * BM + wc * 32 + 8 * fq;
        const float sc = (u.pn < 4) ? 0.125f : 1.0f;
#pragma unroll
        for (int ai = 0; ai < 2; ++ai)
#pragma unroll
            for (int m = 0; m < 4; ++m) { bf16_t* rowp = O + (size_t)(row0 + ai * HALF + m * 16) * ldc + col0;
#pragma unroll
                for (int bj = 0; bj < 2; ++bj) { const f32x4 v0 = acc[ai][bj][m][0] * sc, v1 = acc[ai][bj][m][1] * sc;
                    u32x4 w; w.x = cvt_pk_bf16(v0[0], v0[1]); w.y = cvt_pk_bf16(v0[2], v0[3]); w.z = cvt_pk_bf16(v1[0], v1[1]); w.w = cvt_pk_bf16(v1[2], v1[3]);
                    *(u32x4*)(rowp + bj * HALF) = w; } }
    }
};
__device__ __forceinline__ float silu_mul(float g, float u) { return g * __builtin_amdgcn_rcpf(1.0f + __builtin_amdgcn_exp2f(-1.4426950408889634f * g)) * u; }
struct EpiSwiGLU {
    static constexpr bool PERM = true, AFTER_DRAIN = false;
    bf16_t* O; int ldc;
    __device__ __forceinline__ void operator()(const f32x4 (&acc)[2][2][4][2], const Unit& u, int wr, int wc, int fr, int fq) const {
        const int row0 = u.pm * BM + wr * 64 + fr, col0 = u.pn * HALF + wc * 32 + 8 * fq;
#pragma unroll
        for (int ai = 0; ai < 2; ++ai)
#pragma unroll
            for (int m = 0; m < 4; ++m) { bf16_t* rowp = O + (size_t)(row0 + ai * HALF + m * 16) * ldc + col0;
                const f32x4 g0 = acc[ai][0][m][0], g1 = acc[ai][0][m][1], u0 = acc[ai][1][m][0], u1 = acc[ai][1][m][1];
                u32x4 w; w.x = cvt_pk_bf16(silu_mul(g0[0], u0[0]), silu_mul(g0[1], u0[1])); w.y = cvt_pk_bf16(silu_mul(g0[2], u0[2]), silu_mul(g0[3], u0[3]));
                w.z = cvt_pk_bf16(silu_mul(g1[0], u1[0]), silu_mul(g1[1], u1[1])); w.w = cvt_pk_bf16(silu_mul(g1[2], u1[2]), silu_mul(g1[3], u1[3]));
                *(u32x4*)rowp = w; }
    }
};
struct EpiF32 {
    static constexpr bool PERM = false, AFTER_DRAIN = false;
    float* O; int ldc;
    __device__ __forceinline__ void operator()(const f32x4 (&acc)[2][2][4][2], const Unit& u, int wr, int wc, int fr, int fq) const {
        const int row0 = u.pm * BM + wr * 64 + fr, col0 = u.pn * BM + wc * 32 + 4 * fq;
#pragma unroll
        for (int ai = 0; ai < 2; ++ai)
#pragma unroll
            for (int m = 0; m < 4; ++m) { float* rowp = O + (size_t)(row0 + ai * HALF + m * 16) * ldc + col0;
#pragma unroll
                for (int bj = 0; bj < 2; ++bj)
#pragma unroll
                    for (int n = 0; n < 2; ++n) *(f32x4*)(rowp + bj * HALF + n * 16) = acc[ai][bj][m][n]; }
    }
};

template <class Epi, class Sched, bool ALIGN_EPI = false, bool SP2 = false>
__device__ __forceinline__ void gemm_phase(PG8_LAS unsigned char* lds, const Gemm g, const Sched& S, const Epi& E) {
    int tid_ = threadIdx.x; asm volatile("" : "+v"(tid_));
    const int tid = tid_, wid = __builtin_amdgcn_readfirstlane(tid >> 6), lane = tid & 63, wr = wid >> 2, wc = wid & 3, fr = lane & 15, fq = lane >> 4;
    const int K = g.K, nt = K / BK;
    unsigned voffA[2], voffB[2];
#pragma unroll
    for (int i = 0; i < 2; ++i) { int R, C; stage_rc(tid * 16 + i * 8192, R, C); const int Rb = Epi::PERM ? ((R & ~31) + perm32(R & 31)) : R;
        voffA[i] = (unsigned)(R * K + C) * 2u; voffB[i] = (unsigned)(Rb * K + C) * 2u; }
    const size_t kstep = (size_t)(BK * 2);
    const size_t hstep = (size_t)HALF * K * 2;
    const size_t tstep = 2 * hstep;
    const unsigned ldsw = (unsigned)wid * 1024u;
    const int aoff = lds_byte(wr * 64 + fr, fq * 8), boff = lds_byte(wc * 32 + fr, fq * 8);
#define PG8_SA(b, h) (((b) * 2 + (h)) * HTB)
#define PG8_SB(b, h) ((4 + (b) * 2 + (h)) * HTB)
#define PG8_STAGE(bufoff, gbase, voff) do { _Pragma("unroll") for (int _i = 0; _i < 2; ++_i) \
        __builtin_amdgcn_global_load_lds((const unsigned*)((const char*)(gbase) + (voff)[_i]), (PG8_LAS unsigned*)(lds + (bufoff) + ldsw + _i * 8192), 16, 0, 0); } while (0)
#define PG8_LDA(dst, b, h) do { _Pragma("unroll") for (int m = 0; m < 4; ++m) _Pragma("unroll") for (int k = 0; k < 2; ++k) dst[m][k] = *(const PG8_LAS bf16x8*)(lds + PG8_SA(b, h) + aoff + m * 2048 + k * 1024); } while (0)
#define PG8_LDB(dst, b, h) do { _Pragma("unroll") for (int n = 0; n < 2; ++n) _Pragma("unroll") for (int k = 0; k < 2; ++k) dst[n][k] = *(const PG8_LAS bf16x8*)(lds + PG8_SB(b, h) + boff + n * 2048 + k * 1024); } while (0)
#define PG8_MMA(ai, bj, At, Bt) do { __builtin_amdgcn_s_setprio(1); _Pragma("unroll") for (int m = 0; m < 4; ++m) _Pragma("unroll") for (int n = 0; n < 2; ++n) _Pragma("unroll") for (int k = 0; k < 2; ++k) \
        acc[ai][bj][m][n] = __builtin_amdgcn_mfma_f32_16x16x32_bf16(Bt[n][k], At[m][k], acc[ai][bj][m][n], 0, 0, 0); __builtin_amdgcn_s_setprio(0); } while (0)
#define PG8_WAIT_V(n) asm volatile("s_waitcnt vmcnt(" #n ")" ::: "memory")
#define PG8_WAIT_L(n) asm volatile("s_waitcnt lgkmcnt(" #n ")" ::: "memory")
#define PG8_BAR __builtin_amdgcn_s_barrier()
#define PG8_SCHED __builtin_amdgcn_sched_barrier(0)
    Unit cur, nxt; int ui = 0;
    if (!S.next(0, cur)) return;
    f32x4 acc[2][2][4][2];
#pragma unroll
    for (int a = 0; a < 2; ++a)
#pragma unroll
        for (int b = 0; b < 2; ++b)
#pragma unroll
            for (int m = 0; m < 4; ++m)
#pragma unroll
                for (int n = 0; n < 2; ++n) acc[a][b][m][n] = (f32x4){0.f, 0.f, 0.f, 0.f};
    bf16x8 At[4][2], B0[2][2], B1[2][2];
    const char* cA = (const char*)g.A + (size_t)cur.pm * tstep; const char* cB = (const char*)g.Bt + (size_t)cur.pn * tstep;
    S.a_ready(cur);
    if constexpr (SP2) {
        PG8_STAGE(PG8_SB(0, 0), cB, voffB); PG8_STAGE(PG8_SB(0, 1), cB + hstep, voffB); PG8_STAGE(PG8_SA(0, 0), cA, voffA); PG8_STAGE(PG8_SA(0, 1), cA + hstep, voffA);
        if (wr == 1) PG8_BAR;
        PG8_WAIT_V(2); PG8_BAR;
        PG8_STAGE(PG8_SB(1, 0), cB + kstep, voffB); PG8_STAGE(PG8_SA(1, 0), cA + kstep, voffA); PG8_STAGE(PG8_SB(1, 1), cB + hstep + kstep, voffB);
        PG8_WAIT_V(6); PG8_BAR;
    } else {
        PG8_STAGE(PG8_SB(0, 0), cB, voffB); PG8_STAGE(PG8_SA(0, 0), cA, voffA); PG8_STAGE(PG8_SB(0, 1), cB + hstep, voffB); PG8_STAGE(PG8_SA(0, 1), cA + hstep, voffA);
        if (wr == 1) PG8_BAR;
        PG8_WAIT_V(4); PG8_BAR;
        PG8_STAGE(PG8_SB(1, 0), cB + kstep, voffB); PG8_STAGE(PG8_SA(1, 0), cA + kstep, voffA); PG8_STAGE(PG8_SB(1, 1), cB + hstep + kstep, voffB);
        PG8_WAIT_V(6); PG8_BAR;
    }
    for (;;) {
        const bool has_next = S.next(ui + 1, nxt);
        const char* nA = has_next ? (const char*)g.A + (size_t)nxt.pm * tstep : cA; const char* nB = has_next ? (const char*)g.Bt + (size_t)nxt.pn * tstep : cB;
        for (int t = 0; t < nt; t += 2) {
            const bool last = (t == nt - 2);
            const char* a1 = cA + (size_t)(t + 1) * kstep;
            const char* a2 = last ? nA : cA + (size_t)(t + 2) * kstep; const char* b2 = last ? nB : cB + (size_t)(t + 2) * kstep;
            const char* a3 = a2 + kstep; const char* b3 = b2 + kstep;
            if (last && has_next) S.a_ready(nxt);
            if constexpr (SP2) {
            PG8_LDB(B0, 0, 0); PG8_LDB(B1, 0, 1); PG8_SCHED; PG8_LDA(At, 0, 0); PG8_STAGE(PG8_SA(1, 1), a1 + hstep, voffA);
            PG8_WAIT_V(8); PG8_WAIT_L(0); PG8_BAR; PG8_MMA(0, 0, At, B0); PG8_MMA(0, 1, At, B1); PG8_BAR; PG8_SCHED;
            PG8_LDA(At, 0, 1); PG8_STAGE(PG8_SB(0, 0), b2, voffB); PG8_STAGE(PG8_SB(0, 1), b2 + hstep, voffB); PG8_STAGE(PG8_SA(0, 0), a2, voffA);
            PG8_WAIT_V(8); PG8_WAIT_L(0); PG8_BAR; PG8_MMA(1, 0, At, B0); PG8_MMA(1, 1, At, B1); PG8_BAR; PG8_SCHED;
            PG8_LDB(B0, 1, 0); PG8_LDB(B1, 1, 1); PG8_SCHED; PG8_LDA(At, 1, 0); PG8_STAGE(PG8_SA(0, 1), a2 + hstep, voffA);
            PG8_WAIT_V(8); PG8_WAIT_L(0); PG8_BAR; PG8_MMA(0, 0, At, B0); PG8_MMA(0, 1, At, B1); PG8_BAR; PG8_SCHED;
            PG8_LDA(At, 1, 1); PG8_STAGE(PG8_SB(1, 0), b3, voffB); PG8_STAGE(PG8_SB(1, 1), b3 + hstep, voffB); PG8_STAGE(PG8_SA(1, 0), a3, voffA);
            PG8_WAIT_V(8); PG8_WAIT_L(0); PG8_BAR; PG8_MMA(1, 0, At, B0); PG8_MMA(1, 1, At, B1); PG8_BAR; PG8_SCHED;
            } else {
            PG8_LDB(B0, 0, 0); PG8_SCHED; PG8_LDA(At, 0, 0); PG8_STAGE(PG8_SA(1, 1), a1 + hstep, voffA);
            PG8_WAIT_L(8); PG8_BAR; PG8_WAIT_L(0); PG8_MMA(0, 0, At, B0); PG8_BAR; PG8_SCHED;
            PG8_LDB(B1, 0, 1); PG8_STAGE(PG8_SB(0, 0), b2, voffB);
            PG8_BAR; PG8_WAIT_L(0); PG8_MMA(0, 1, At, B1); PG8_BAR;
            PG8_LDA(At, 0, 1); PG8_STAGE(PG8_SA(0, 0), a2, voffA);
            PG8_BAR; PG8_WAIT_L(0); PG8_MMA(1, 0, At, B0); PG8_BAR; PG8_SCHED;
            PG8_STAGE(PG8_SB(0, 1), b2 + hstep, voffB);
            PG8_WAIT_V(6); PG8_BAR; PG8_MMA(1, 1, At, B1); PG8_BAR;
            PG8_LDB(B0, 1, 0); PG8_SCHED; PG8_LDA(At, 1, 0); PG8_STAGE(PG8_SA(0, 1), a2 + hstep, voffA);
            PG8_WAIT_L(8); PG8_BAR; PG8_WAIT_L(0); PG8_MMA(0, 0, At, B0); PG8_BAR; PG8_SCHED;
            PG8_LDB(B1, 1, 1); PG8_STAGE(PG8_SB(1, 0), b3, voffB);
            PG8_BAR; PG8_WAIT_L(0); PG8_MMA(0, 1, At, B1); PG8_BAR;
            PG8_LDA(At, 1, 1); PG8_STAGE(PG8_SA(1, 0), a3, voffA);
            PG8_BAR; PG8_WAIT_L(0); PG8_MMA(1, 0, At, B0); PG8_BAR; PG8_SCHED;
            PG8_STAGE(PG8_SB(1, 1), b3 + hstep, voffB);
            PG8_WAIT_V(6); PG8_BAR; PG8_MMA(1, 1, At, B1); PG8_BAR;
            }
        }
        if constexpr (ALIGN_EPI) { if (wr == 0) PG8_BAR; }
        if constexpr (!Epi::AFTER_DRAIN) { E(acc, cur, wr, wc, fr, fq); S.done(cur); }
        if (!has_next) break;
#pragma unroll
        for (int a = 0; a < 2; ++a)
#pragma unroll
            for (int b = 0; b < 2; ++b)
#pragma unroll
                for (int m = 0; m < 4; ++m)
#pragma unroll
                    for (int n = 0; n < 2; ++n) acc[a][b][m][n] = (f32x4){0.f, 0.f, 0.f, 0.f};
        cur = nxt; cA = nA; cB = nB; ++ui;
        if constexpr (ALIGN_EPI) { if (wr == 1) PG8_BAR; }
    }
    PG8_WAIT_V(0);
    if constexpr (!ALIGN_EPI) { if (wr == 0) PG8_BAR; }
    PG8_BAR;
    if constexpr (Epi::AFTER_DRAIN) { E.fused(acc, cur, wr, wc, fr, fq, lds, wid, lane); S.done(cur); }
#undef PG8_SA
#undef PG8_SB
#undef PG8_STAGE
#undef PG8_LDA
#undef PG8_LDB
#undef PG8_MMA
#undef PG8_WAIT_V
#undef PG8_WAIT_L
#undef PG8_BAR
#undef PG8_SCHED
}
}

constexpr int NWAVES = 8, NTHREADS = 512;
constexpr int BATCH = 8, SEQ = 2048, DM = 1024, NH = 16, HD = 64, FF = 2816, DEPTH_ = 2;
constexpr int M = BATCH * SEQ;
constexpr int GRID_W = 64, GRID_ROWS = SEQ / GRID_W;
constexpr float RMS_EPS = 1e-6f, LOG2E = 1.4426950408889634f, NEG_BIG = -1e30f;
constexpr size_t MiB = 1u << 20;
constexpr size_t WS_W = 0;
constexpr size_t W_QKV = 0;
constexpr size_t W0_O = 6 * MiB, W0_GU = 8 * MiB, W0_DN = 19 * MiB;
constexpr size_t W1_O = 18 * MiB, W1_GU = 20 * MiB, W1_DN = 31 * MiB;
constexpr size_t WS_L = 38 * MiB;
constexpr size_t WS_BAR = 39 * MiB, BAR_ZERO_BYTES = 65536;
constexpr size_t WS_XN = 40 * MiB;
constexpr size_t WS_R1 = 72 * MiB;
constexpr size_t WS_R2 = 168 * MiB;
constexpr size_t WS_END = 232 * MiB;
constexpr int LDS_BYTES = 147456;
#define GAS __attribute__((address_space(1)))
#define LAS __attribute__((address_space(3)))
typedef unsigned short bf16;
typedef unsigned v4u __attribute__((ext_vector_type(4)));
typedef unsigned v2u __attribute__((ext_vector_type(2)));
typedef float f32x4 __attribute__((ext_vector_type(4)));
typedef short bf16x8 __attribute__((ext_vector_type(8)));
typedef short bf16x4 __attribute__((ext_vector_type(4)));
#define LDS_WAIT() asm volatile("s_waitcnt lgkmcnt(0)" ::: "memory")
__device__ __forceinline__ unsigned f2bf(float f) { unsigned u = __builtin_bit_cast(unsigned, f); return (u + 0x7fffu + ((u >> 16) & 1u)) >> 16; }
__device__ __forceinline__ unsigned pk2(float lo, float hi) { return f2bf(lo) | (f2bf(hi) << 16); }
__device__ __forceinline__ float wave_sum(float v) {
#pragma unroll
    for (int o = 1; o < 64; o <<= 1) v += __shfl_xor(v, o);
    return v;
}
#define XB_TMO      128
#define XB_XCNT(j)  (256  + 64 * (j))
#define XB_XSUB(j)  (1280 + 64 * (j))
#define XB_XGEN(j)  (2304 + 64 * (j))
#define XB_TOP      3328
#define XB_TOPGEN   3392
#define XCD_BAR_WORDS 3456
#define XB_SPIN_CAP (1u << 18)

__device__ __forceinline__ unsigned xb_ld(unsigned* p)              { return __hip_atomic_load(p, __ATOMIC_RELAXED, __HIP_MEMORY_SCOPE_AGENT); }
__device__ __forceinline__ unsigned xb_add(unsigned* p, unsigned v) { return __hip_atomic_fetch_add(p, v, __ATOMIC_RELAXED, __HIP_MEMORY_SCOPE_AGENT); }
__device__ __forceinline__ unsigned xb_xcc_id() { return (unsigned)__builtin_amdgcn_s_getreg((3 << 11) | 20) & 0xFu; }
#define XB_SPIN(cond, bar) do { unsigned _sp = 0; while (cond) { __builtin_amdgcn_s_sleep(1); \
    if ((++_sp & 255u) == 0u) { if (xb_ld(&(bar)[XB_TMO])) break; if (_sp > XB_SPIN_CAP) { atomicAdd(&(bar)[XB_TMO], 1u); break; } } } } while (0)

struct XcdBarrier {
    unsigned* bar; unsigned x;
    volatile LAS unsigned* st;
};

__device__ __forceinline__ XcdBarrier xcd_barrier_post(unsigned* bar, volatile LAS unsigned* st) {
    XcdBarrier b; b.bar = bar; b.x = xb_xcc_id(); b.st = st;
    if (threadIdx.x == 0) (void)xb_add(&bar[XB_XCNT(b.x)], 1u);
    return b;
}
__device__ __forceinline__ void xcd_barrier_complete(unsigned* bar, unsigned x, unsigned& nloc, unsigned& nx) {
    const unsigned G = gridDim.x * gridDim.y * gridDim.z;
    unsigned sum, cnt, mine, sp = 0u;
    for (;;) {
        sum = 0u; cnt = 0u; mine = 0u;
#pragma unroll
        for (unsigned j = 0; j < 16; ++j) { const unsigned c = xb_ld(&bar[XB_XCNT(j)]); sum += c; cnt += (c > 0u) ? 1u : 0u; mine = (j == x) ? c : mine; }
        if (sum == G) break;
        __builtin_amdgcn_s_sleep(1);
        if ((++sp & 255u) == 0u) { if (xb_ld(&bar[XB_TMO])) break; if (sp > XB_SPIN_CAP) { atomicAdd(&bar[XB_TMO], 1u); break; } }
    }
    nloc = mine > 0u ? mine : 1u; nx = cnt > 0u ? cnt : 1u;
}

__device__ __forceinline__ void xcd_barrier(const XcdBarrier& b) {
    asm volatile("s_waitcnt vmcnt(0)" ::: "memory");
    __syncthreads();
    if (threadIdx.x == 0) {
        unsigned* bar = b.bar;
        __builtin_amdgcn_s_waitcnt(0);
        unsigned nloc = b.st[0], nx = b.st[1];
        if (nloc == 0u) { xcd_barrier_complete(bar, b.x, nloc, nx); b.st[0] = nloc; b.st[1] = nx; }
        const unsigned old = xb_add(&bar[XB_XSUB(b.x)], 1u);
        const unsigned gen = old / nloc;
        if (old + 1u == (gen + 1u) * nloc) {
            __builtin_amdgcn_fence(__ATOMIC_RELEASE, "agent");
            asm volatile("s_waitcnt vmcnt(0)" ::: "memory");
            const unsigned og = xb_add(&bar[XB_TOP], 1u);
            const unsigned tg = og / nx;
            if (og + 1u == (tg + 1u) * nx) xb_add(&bar[XB_TOPGEN], 1u);
            else XB_SPIN(xb_ld(&bar[XB_TOPGEN]) == tg, bar);
            __builtin_amdgcn_fence(__ATOMIC_ACQUIRE, "agent");
            xb_add(&bar[XB_XGEN(b.x)], 1u);
            asm volatile("s_waitcnt vmcnt(0)" ::: "memory");
        } else {
            XB_SPIN(xb_ld(&bar[XB_XGEN(b.x)]) == gen, bar);
            __builtin_amdgcn_fence(__ATOMIC_ACQUIRE, "agent");
            asm volatile("s_waitcnt vmcnt(0)" ::: "memory");
        }
    }
    __syncthreads();
}

__device__ __forceinline__ void transpose_item(const float* W, int ldn, int K, int k0, int c0, bf16* WT, int drow0, LAS float* scr, int lane) {
#pragma unroll 8
    for (int i = 0; i < 32; ++i) { const int kk = 2 * i + (lane >> 5); scr[kk * 33 + (lane & 31)] = W[(size_t)(k0 + kk) * ldn + c0 + (lane & 31)]; }
    LDS_WAIT(); asm volatile("" ::: "memory");
    const int c = lane & 7;
#pragma unroll
    for (int j = 0; j < 4; ++j) { const int n = (lane >> 3) + 8 * j; const LAS float* s = scr + (8 * c) * 33 + n;
        v4u o; o.x = pk2(s[0 * 33], s[1 * 33]); o.y = pk2(s[2 * 33], s[3 * 33]); o.z = pk2(s[4 * 33], s[5 * 33]); o.w = pk2(s[6 * 33], s[7 * 33]);
        *(GAS v4u*)(WT + (size_t)(drow0 + n) * K + k0 + 8 * c) = o; }
    LDS_WAIT(); asm volatile("" ::: "memory");
}
__device__ __forceinline__ void convert_weights(int layer, const float* wqkv, int nqkv, const float* wo, const float* wg, const float* wu, const float* wd,
                                                unsigned char* ws, LAS float* scr, int gw, int ngw, int lane) {
    bf16* Tqkv = (bf16*)(ws + WS_W + W_QKV);
    bf16* To = (bf16*)(ws + WS_W + (layer == 0 ? W0_O : W1_O));
    bf16* Tgu = (bf16*)(ws + WS_W + (layer == 0 ? W0_GU : W1_GU));
    bf16* Tdn = (bf16*)(ws + WS_W + (layer == 0 ? W0_DN : W1_DN));
    const int I_QKV = (DM / 64) * (nqkv / 32), I_O = (DM / 64) * (DM / 32), I_G = (DM / 64) * (FF / 32), I_D = (FF / 64) * (DM / 32);
    const int NIT = I_QKV + I_O + 2 * I_G + I_D;
    for (int it = gw; it < NIT; it += ngw) {
        int r = it;
        if (r < I_QKV) { const int nb = nqkv / 32, kb = r / nb, cb = r % nb; transpose_item(wqkv, nqkv, DM, 64 * kb, 32 * cb, Tqkv, 32 * cb, scr, lane); continue; } r -= I_QKV;
        if (r < I_O) { const int nb = DM / 32, kb = r / nb, cb = r % nb; transpose_item(wo, DM, DM, 64 * kb, 32 * cb, To, 32 * cb, scr, lane); continue; } r -= I_O;
        if (r < 2 * I_G) { const int up = r >= I_G; if (up) r -= I_G; const int nb = FF / 32, kb = r / nb, cb = r % nb, c0 = 32 * cb;
            transpose_item(up ? wu : wg, FF, DM, 64 * kb, c0, Tgu, (c0 >> 7) * 256 + (up ? 128 : 0) + (c0 & 127), scr, lane); continue; } r -= 2 * I_G;
        { const int nb = DM / 32, kb = r / nb, cb = r % nb; transpose_item(wd, DM, FF, 64 * kb, 32 * cb, Tdn, 32 * cb, scr, lane); }
    }
}
__device__ __forceinline__ void norm_rows(const float* x, const float* g, bf16* xn, int gw, int ngw, int lane) {
    f32x4 gv[4];
#pragma unroll
    for (int j = 0; j < 4; ++j) gv[j] = ((const f32x4*)g)[lane + 64 * j];
    for (int m = gw; m < M; m += ngw) {
        const f32x4* xr = (const f32x4*)(x + (size_t)m * DM) + lane;
        f32x4 v[4]; float s = 0.f;
#pragma unroll
        for (int j = 0; j < 4; ++j) { v[j] = xr[64 * j]; s += (v[j].x * v[j].x + v[j].y * v[j].y) + (v[j].z * v[j].z + v[j].w * v[j].w); }
        const float r = 1.0f / sqrtf(wave_sum(s) * (1.0f / DM) + RMS_EPS);
        v2u* o8 = (v2u*)(xn + (size_t)m * DM) + lane;
#pragma unroll
        for (int j = 0; j < 4; ++j) { const f32x4 y = v[j] * r * gv[j]; v2u w; w.x = pk2(y.x, y.y); w.y = pk2(y.z, y.w); o8[64 * j] = w; }
    }
}
__device__ __forceinline__ void resid_norm_rows(const float* h, const float* gpost, const float* xin, float* xout, const float* gnext, bf16* xn, int gw, int ngw, int lane) {
    f32x4 gp[4], gn[4];
#pragma unroll
    for (int j = 0; j < 4; ++j) { gp[j] = ((const f32x4*)gpost)[lane + 64 * j]; gn[j] = gnext ? ((const f32x4*)gnext)[lane + 64 * j] : (f32x4){0.f, 0.f, 0.f, 0.f}; }
    for (int m = gw; m < M; m += ngw) {
        const f32x4* hr = (const f32x4*)(h + (size_t)m * DM) + lane;
        const f32x4* xr = (const f32x4*)(xin + (size_t)m * DM) + lane;
        f32x4 v[4], xv[4]; float s = 0.f;
#pragma unroll
        for (int j = 0; j < 4; ++j) { v[j] = hr[64 * j]; xv[j] = xr[64 * j]; s += (v[j].x * v[j].x + v[j].y * v[j].y) + (v[j].z * v[j].z + v[j].w * v[j].w); }
        const float r = 1.0f / sqrtf(wave_sum(s) * (1.0f / DM) + RMS_EPS);
        f32x4* xo = (f32x4*)(xout + (size_t)m * DM) + lane; float s2 = 0.f;
#pragma unroll
        for (int j = 0; j < 4; ++j) { xv[j] = xv[j] + v[j] * r * gp[j]; xo[64 * j] = xv[j]; s2 += (xv[j].x * xv[j].x + xv[j].y * xv[j].y) + (xv[j].z * xv[j].z + xv[j].w * xv[j].w); }
        if (gnext) {
            const float r2 = 1.0f / sqrtf(wave_sum(s2) * (1.0f / DM) + RMS_EPS);
            v2u* o8 = (v2u*)(xn + (size_t)m * DM) + lane;
#pragma unroll
            for (int j = 0; j < 4; ++j) { const f32x4 y = xv[j] * r2 * gn[j]; v2u w; w.x = pk2(y.x, y.y); w.y = pk2(y.z, y.w); o8[64 * j] = w; }
        }
    }
}
__device__ __forceinline__ f32x4 mfma16(bf16x8 a, bf16x8 b, f32x4 c) { return __builtin_amdgcn_mfma_f32_16x16x32_bf16(a, b, c, 0, 0, 0); }
__device__ __forceinline__ unsigned cvtpk(float lo, float hi) { return pg8::cvt_pk_bf16(lo, hi); }
__device__ __forceinline__ void vt_write8(LAS unsigned* dst, int pitch_dw, v4u a, v4u b) {
#pragma unroll
    for (int w = 0; w < 4; ++w) { dst[(2 * w) * pitch_dw] = (a[w] & 0xffffu) | (b[w] << 16); dst[(2 * w + 1) * pitch_dw] = (a[w] >> 16) | (b[w] & 0xffff0000u); }
}
__device__ __forceinline__ void na_attn_phase(LAS unsigned char* lds, const bf16* QKV, const float* rpb, bf16* O, int vcu, int G, int tid) {
    constexpr int KP = 520, LDQ = 3 * DM;
    LAS bf16* Vt = (LAS bf16*)lds;
    LAS float* tbl = (LAS float*)(lds + 2 * 64 * KP * 2);
    const int lane = tid & 63, wid = __builtin_amdgcn_readfirstlane(tid >> 6), c16 = lane & 15, g = lane >> 4;
    const int hh = wid >> 2, j = wid & 3;
    const int w0 = (j == 0) ? 0 : (j == 1) ? 8 : (j == 2) ? 24 : 32;
    for (int u = vcu; u < BATCH * GRID_ROWS * 8; u += G) {
        const int hp = u & 7, i = (u >> 3) & 31, b = u >> 8;
        const int rs = min(max(i - 4, 0), GRID_ROWS - 8);
        const int h = 2 * hp + hh;
        const size_t tb = (size_t)b * SEQ + rs * GRID_W;
        __syncthreads();
#pragma unroll 2
        for (int it = 0; it < 8; ++it) {
            const int p = it * 2 + (tid >> 8), kp = tid & 255;
            const bf16* src = QKV + (tb + 2 * kp) * LDQ + 2 * DM + hp * 128 + p * 8;
            const v4u a = *(const v4u*)src, bb = *(const v4u*)(src + LDQ);
            vt_write8((LAS unsigned*)(Vt + (p * 8) * KP + 2 * kp), KP / 2, a, bb);
        }
        for (int idx = tid; idx < 2 * 465; idx += NTHREADS) { const int h2 = idx >= 465, k = idx - h2 * 465; tbl[h2 * 512 + k] = rpb[(2 * hp + h2) * 465 + k] * LOG2E; }
        const size_t qtok = (size_t)b * SEQ + i * GRID_W + 16 * j + c16;
        const bf16* qp = QKV + qtok * LDQ + h * HD + g * 8;
        const bf16x8 q0 = *(const bf16x8*)qp, q1 = *(const bf16x8*)(qp + 32);
        f32x4 s[16];
#pragma unroll
        for (int t = 0; t < 16; ++t) {
            const bf16* kp_ = QKV + (tb + (t >> 1) * GRID_W + w0 + 16 * (t & 1) + c16) * LDQ + DM + h * HD + g * 8;
            const bf16x8 k0 = *(const bf16x8*)kp_, k1 = *(const bf16x8*)(kp_ + 32);
            s[t] = mfma16(k0, q0, (f32x4){0.f, 0.f, 0.f, 0.f}); s[t] = mfma16(k1, q1, s[t]);
        }
        __syncthreads();
        const int qc = 16 * j + c16, cs = min(max(qc - 8, 0), GRID_W - 16);
        const LAS float* tb_ = tbl + hh * 512;
        float mx = NEG_BIG;
#pragma unroll
        for (int t = 0; t < 16; ++t) {
            const int brow = (rs + (t >> 1) - i + 7) * 31;
#pragma unroll
            for (int jj = 0; jj < 4; ++jj) {
                const int kc = w0 + 16 * (t & 1) + 4 * g + jj; const bool valid = (kc >= cs) && (kc < cs + 16);
                const int bidx = brow + min(max(kc - qc + 15, 0), 30);
                const float v = valid ? s[t][jj] * LOG2E + tb_[bidx] : NEG_BIG; s[t][jj] = v; mx = fmaxf(mx, v);
            }
        }
        mx = fmaxf(mx, __shfl_xor(mx, 16)); mx = fmaxf(mx, __shfl_xor(mx, 32));
        float l = 0.f;
#pragma unroll
        for (int t = 0; t < 16; ++t)
#pragma unroll
            for (int jj = 0; jj < 4; ++jj) { const float p = __builtin_amdgcn_exp2f(s[t][jj] - mx); s[t][jj] = p; l += p; }
        l += __shfl_xor(l, 16); l += __shfl_xor(l, 32);
        f32x4 o[4];
#pragma unroll
        for (int dt = 0; dt < 4; ++dt) o[dt] = (f32x4){0.f, 0.f, 0.f, 0.f};
#pragma unroll
        for (int c = 0; c < 8; ++c) {
            v4u pw; pw.x = cvtpk(s[2 * c][0], s[2 * c][1]); pw.y = cvtpk(s[2 * c][2], s[2 * c][3]); pw.z = cvtpk(s[2 * c + 1][0], s[2 * c + 1][1]); pw.w = cvtpk(s[2 * c + 1][2], s[2 * c + 1][3]);
            const bf16x8 pf = __builtin_bit_cast(bf16x8, pw);
#pragma unroll
            for (int dt = 0; dt < 4; ++dt) {
                const LAS bf16* vp = Vt + (hh * 64 + dt * 16 + c16) * KP + c * 64 + w0 + 4 * g;
                const v2u lo = *(const LAS v2u*)vp, hi = *(const LAS v2u*)(vp + 16);
                const v4u vv = (v4u){lo.x, lo.y, hi.x, hi.y};
                o[dt] = mfma16(__builtin_bit_cast(bf16x8, vv), pf, o[dt]);
            }
        }
        const float rl = 1.0f / l;
        bf16* op = O + qtok * DM + h * HD + 4 * g;
#pragma unroll
        for (int dt = 0; dt < 4; ++dt) { v2u w; w.x = cvtpk(o[dt][0] * rl, o[dt][1] * rl); w.y = cvtpk(o[dt][2] * rl, o[dt][3] * rl); *(v2u*)(op + dt * 16) = w; }
    }
}
__device__ __forceinline__ void dil_attn_phase(LAS unsigned char* lds, const bf16* QKV, float* Oacc, float* Lacc, bf16* Obf, int gi, int vcu, int G, int tid) {
    constexpr int KP2 = 280, LDQ = 3 * DM;
    LAS bf16* Vt = (LAS bf16*)lds;
    const int lane = tid & 63, wid = __builtin_amdgcn_readfirstlane(tid >> 6), c16 = lane & 15, g = lane >> 4;
    const int dsh = 2 * gi, dil = 1 << dsh, L = SEQ >> dsh, nqb = L >> 7, qsh = 4 - dsh;
    for (int u = vcu; u < 2048; u += G) {
        const int h = u & 15, rest = u >> 4, qb = rest & (nqb - 1), r = (rest >> qsh) & (dil - 1), b = rest >> 4;
        const int kbase = 128 * qb - 80;
        const size_t tb = (size_t)b * SEQ + r;
        __syncthreads();
#pragma unroll
        for (int it = 0; it < 3; ++it) {
            const int idx = it * NTHREADS + tid;
            if (idx < 1088) {
                const int p = idx / 136, kp = idx - p * 136, ma = kbase + 2 * kp, mb = ma + 1;
                v4u a = (v4u){0u, 0u, 0u, 0u}, bb = (v4u){0u, 0u, 0u, 0u};
                if (ma >= 0 && ma < L) a = *(const v4u*)(QKV + (tb + (size_t)ma * dil) * LDQ + 2 * DM + h * HD + p * 8);
                if (mb >= 0 && mb < L) bb = *(const v4u*)(QKV + (tb + (size_t)mb * dil) * LDQ + 2 * DM + h * HD + p * 8);
                vt_write8((LAS unsigned*)(Vt + (p * 8) * KP2 + 2 * kp), KP2 / 2, a, bb);
            }
        }
        const int m0 = 128 * qb + 16 * wid, m = m0 + c16;
        const size_t qtok = tb + (size_t)m * dil;
        const bf16* qp = QKV + qtok * LDQ + h * HD + g * 8;
        const bf16x8 q0 = *(const bf16x8*)qp, q1 = *(const bf16x8*)(qp + 32);
        f32x4 s[10];
#pragma unroll
        for (int t = 0; t < 10; ++t) {
            const int mk = min(max(m0 - 80 + 16 * t + c16, 0), L - 1);
            const bf16* kp_ = QKV + (tb + (size_t)mk * dil) * LDQ + DM + h * HD + g * 8;
            const bf16x8 k0 = *(const bf16x8*)kp_, k1 = *(const bf16x8*)(kp_ + 32);
            s[t] = mfma16(k0, q0, (f32x4){0.f, 0.f, 0.f, 0.f}); s[t] = mfma16(k1, q1, s[t]);
        }
        const float slope2 = __builtin_amdgcn_exp2f(-0.5f * (float)(h + 1)) * (float)dil * LOG2E;
        float mx = NEG_BIG;
#pragma unroll
        for (int t = 0; t < 10; ++t)
#pragma unroll
            for (int jj = 0; jj < 4; ++jj) {
                const int mk = m0 - 80 + 16 * t + 4 * g + jj, dist = abs(m - mk); const bool valid = (dist <= 64) && (mk >= 0) && (mk < L);
                const float v = valid ? s[t][jj] * LOG2E - slope2 * (float)dist : NEG_BIG; s[t][jj] = v; mx = fmaxf(mx, v);
            }
        mx = fmaxf(mx, __shfl_xor(mx, 16)); mx = fmaxf(mx, __shfl_xor(mx, 32));
        float l = 0.f;
#pragma unroll
        for (int t = 0; t < 10; ++t)
#pragma unroll
            for (int jj = 0; jj < 4; ++jj) { const float p = __builtin_amdgcn_exp2f(s[t][jj] - mx); s[t][jj] = p; l += p; }
        l += __shfl_xor(l, 16); l += __shfl_xor(l, 32);
        __syncthreads();
        f32x4 o[4];
#pragma unroll
        for (int dt = 0; dt < 4; ++dt) o[dt] = (f32x4){0.f, 0.f, 0.f, 0.f};
#pragma unroll
        for (int c = 0; c < 5; ++c) {
            v4u pw; pw.x = cvtpk(s[2 * c][0], s[2 * c][1]); pw.y = cvtpk(s[2 * c][2], s[2 * c][3]); pw.z = cvtpk(s[2 * c + 1][0], s[2 * c + 1][1]); pw.w = cvtpk(s[2 * c + 1][2], s[2 * c + 1][3]);
            const bf16x8 pf = __builtin_bit_cast(bf16x8, pw);
#pragma unroll
            for (int dt = 0; dt < 4; ++dt) {
                const LAS bf16* vp = Vt + (dt * 16 + c16) * KP2 + 16 * wid + 32 * c + 4 * g;
                const v2u lo = *(const LAS v2u*)vp, hi = *(const LAS v2u*)(vp + 16);
                const v4u vv = (v4u){lo.x, lo.y, hi.x, hi.y};
                o[dt] = mfma16(__builtin_bit_cast(bf16x8, vv), pf, o[dt]);
            }
        }
        const float lse2 = mx + __builtin_log2f(l);
        float wn = 1.0f / l, wo = 0.f, lnew = lse2;
        float* lp = Lacc + qtok * NH + h;
        if (gi > 0) { const float lo_ = *lp, mm = fmaxf(lo_, lse2); lnew = mm + __builtin_log2f(__builtin_amdgcn_exp2f(lo_ - mm) + __builtin_amdgcn_exp2f(lse2 - mm));
            wo = __builtin_amdgcn_exp2f(lo_ - lnew); wn *= __builtin_amdgcn_exp2f(lse2 - lnew); }
        float* oa = Oacc + qtok * DM + h * HD + 4 * g;
#pragma unroll
        for (int dt = 0; dt < 4; ++dt) {
            f32x4 v = o[dt] * wn;
            if (gi > 0) v += *(const f32x4*)(oa + dt * 16) * wo;
            if (gi < 2) *(f32x4*)(oa + dt * 16) = v;
            else { v2u w; w.x = cvtpk(v[0], v[1]); w.y = cvtpk(v[2], v[3]); *(v2u*)(Obf + qtok * DM + h * HD + 4 * g + dt * 16) = w; }
        }
        if (gi < 2 && g == 0) *lp = lnew;
    }
}
constexpr int N_PHASES = 19;
struct Args { const float* in[13]; float* out; unsigned char* ws; int ph_lo, ph_hi; };
static_assert(sizeof(Args) == 15 * 8 + 8, "Args has no padding");
__global__ void __launch_bounds__(NTHREADS, 2) mk_fwd(Args a) {
    extern __shared__ __attribute__((aligned(16))) unsigned char lds_raw[];
    LAS unsigned char* lds = (LAS unsigned char*)lds_raw;
    cg::grid_group grid = cg::this_grid();
    volatile LAS unsigned* MISC = (volatile LAS unsigned*)(lds + LDS_BYTES - 64);
    if (threadIdx.x < 2) MISC[threadIdx.x] = 0u;
    __syncthreads();
    XcdBarrier bar = xcd_barrier_post((unsigned*)(a.ws + WS_BAR), MISC);
    const int tid0 = threadIdx.x;
    const int G = gridDim.x, bx = blockIdx.x, vcu = (G % 8 == 0) ? (bx % 8) * (G / 8) + bx / 8 : bx;
    const int ngw = G * NWAVES;
    unsigned char* ws = a.ws;
    const float* x = a.in[0];
    bf16* XN = (bf16*)(ws + WS_XN); bf16* R1 = (bf16*)(ws + WS_R1); float* R2 = (float*)(ws + WS_R2); float* LA = (float*)(ws + WS_L);
    for (int ph = a.ph_lo; ph < a.ph_hi; ++ph) {
        int tid = tid0; asm volatile("" : "+v"(tid));
        const int lane = tid & 63, wave = __builtin_amdgcn_readfirstlane(tid >> 6), gw = vcu * NWAVES + wave;
        LAS float* scr = (LAS float*)(lds + wave * 16384);
        const int layer = ph >= 8 ? 1 : 0;
        const bf16* Wqkv = (const bf16*)(ws + WS_W + W_QKV);
        const bf16* Wo = (const bf16*)(ws + WS_W + (layer ? W1_O : W0_O));
        const bf16* Wgu = (const bf16*)(ws + WS_W + (layer ? W1_GU : W0_GU));
        const bf16* Wdn = (const bf16*)(ws + WS_W + (layer ? W1_DN : W0_DN));
        switch (ph) {
        case 0:
            convert_weights(0, a.in[5], 3 * DM, a.in[6], a.in[10], a.in[11], a.in[12], ws, scr, gw, ngw, lane);
            norm_rows(x, a.in[1], XN, gw, ngw, lane);
            break;
        case 1: case 8: case 10: case 12: {
            const int gi = ph == 1 ? 0 : (ph - 8) >> 1;
            pg8::Gemm g{XN, Wqkv + (size_t)gi * 3 * DM * DM, M, 3 * DM, DM}; pg8::StaticOrder S; S.init(M, 3 * DM, G, bx);
            pg8::EpiQKV E{R1, 3 * DM};
            for (int rep = 0; rep < REP_GEMM; ++rep) pg8::gemm_phase<pg8::EpiQKV, pg8::StaticOrder, true, true>(lds, g, S, E);
        } break;
        case 2:
            for (int rep = 0; rep < REP_ATTN; ++rep) na_attn_phase(lds, R1, a.in[7], XN, vcu, G, tid);
            break;
        case 3: case 14: {
            pg8::Gemm g{XN, Wo, M, DM, DM}; pg8::StaticOrder S; S.init(M, DM, G, bx);
            pg8::EpiF32 E{R2, DM};
            for (int rep = 0; rep < REP_GEMM; ++rep) pg8::gemm_phase<pg8::EpiF32, pg8::StaticOrder, true, true>(lds, g, S, E);
        } break;
        case 4: for (int rep = 0; rep < REP_EW; ++rep) resid_norm_rows(R2, a.in[2], x, a.out, a.in[3], XN, gw, ngw, lane); break;
        case 15: resid_norm_rows(R2, a.in[2] + DM, a.out, a.out, a.in[3] + DM, XN, gw, ngw, lane); break;
        case 5: case 16: {
            pg8::Gemm g{XN, Wgu, M, 2 * FF, DM}; pg8::StaticOrder S; S.init(M, 2 * FF, G, bx);
            pg8::EpiSwiGLU E{R1, FF};
            for (int rep = 0; rep < REP_GEMM; ++rep) pg8::gemm_phase<pg8::EpiSwiGLU, pg8::StaticOrder, true, true>(lds, g, S, E);
        } break;
        case 6: case 17: {
            pg8::Gemm g{R1, Wdn, M, DM, FF}; pg8::StaticOrder S; S.init(M, DM, G, bx);
            pg8::EpiF32 E{R2, DM};
            for (int rep = 0; rep < REP_GEMM; ++rep) pg8::gemm_phase<pg8::EpiF32, pg8::StaticOrder, true, true>(lds, g, S, E);
        } break;
        case 7:
            resid_norm_rows(R2, a.in[4], a.out, a.out, a.in[1] + DM, XN, gw, ngw, lane);
            convert_weights(1, a.in[8], 9 * DM, a.in[9], a.in[10] + (size_t)DM * FF, a.in[11] + (size_t)DM * FF, a.in[12] + (size_t)DM * FF, ws, scr, gw, ngw, lane);
            break;
        case 9: case 11: case 13:
            for (int rep = 0; rep < (ph == 9 ? REP_ATTN : 1); ++rep) dil_attn_phase(lds, R1, R2, LA, XN, (ph - 9) >> 1, vcu, G, tid);
            break;
        case 18: resid_norm_rows(R2, a.in[4] + DM, a.out, a.out, nullptr, nullptr, gw, ngw, lane); break;
        default: break;
        }
        if (ph + 1 < a.ph_hi) for (int rep = 0; rep < REP_SYNC; ++rep) {
            if (a.ph_hi > N_PHASES) grid.sync();
            else xcd_barrier(bar);
        }
    }
}

extern "C" void kernel_launch(void* const* d_in, const int* in_sizes, int n_in, void* d_out, int out_size, void* d_ws, size_t ws_size, hipStream_t stream) {
    static int grid = 0;
    if (grid == 0) {
        if (n_in != 13 || in_sizes[0] != M * DM || out_size != M * DM || ws_size < WS_END) { fprintf(stderr, "kernel_launch: unexpected shapes / workspace (n_in %d, ws %zu)\n", n_in, ws_size); grid = -1; return; }
        int dev = 0, cus = 0, per_cu = 0;
        if (hipGetDevice(&dev) != hipSuccess || hipDeviceGetAttribute(&cus, hipDeviceAttributeMultiprocessorCount, dev) != hipSuccess) { grid = -1; return; }
        if (hipFuncSetAttribute((const void*)mk_fwd, hipFuncAttributeMaxDynamicSharedMemorySize, LDS_BYTES) != hipSuccess) { fprintf(stderr, "kernel_launch: hipFuncSetAttribute failed\n"); grid = -1; return; }
        if (hipOccupancyMaxActiveBlocksPerMultiprocessor(&per_cu, (const void*)mk_fwd, NTHREADS, LDS_BYTES) != hipSuccess || per_cu < 1) per_cu = 1;
        (void)hipGetLastError();
        grid = cus * per_cu;
    }
    if (grid < 0) return;
    Args a{};
    for (int i = 0; i < 13; ++i) a.in[i] = (const float*)d_in[i];
    a.out = (float*)d_out; a.ws = (unsigned char*)d_ws; a.ph_lo = 0; a.ph_hi = N_PHASES;
    if (hipMemsetAsync((char*)d_ws + WS_BAR, 0, BAR_ZERO_BYTES, stream) != hipSuccess) { fprintf(stderr, "kernel_launch: memset of the barrier words failed\n"); return; }
    void* args[] = {&a};
    hipError_t e = hipLaunchCooperativeKernel((const void*)mk_fwd, dim3(grid), dim3(NTHREADS), args, LDS_BYTES, stream);
    if (e != hipSuccess) fprintf(stderr, "cooperative launch failed: %s (grid %d)\n", hipGetErrorString(e), grid);
}
```
